# Optimizing an MI355X kernel written in HIP

```python
import math
import jax, jax.numpy as jnp
from jax import lax
import numpy as np

D_MODEL = 1024
BATCH = 1
SEQ = 16384
DEPTH = 2

N_A_LAYERS = DEPTH // 2
N_B_LAYERS = DEPTH - N_A_LAYERS
PLE_DIM = 256
DN_ALPHA = (2.0 * DEPTH) ** 0.25
DN_BETA = (8.0 * DEPTH) ** -0.25
NORM_EPS = 1e-5

ML_HEADS = 8
ML_QK_DIM = D_MODEL // (2 * ML_HEADS)
ML_V_DIM = D_MODEL // ML_HEADS
ML_CHUNK = 64
ML_Q_END = ML_HEADS * ML_QK_DIM
ML_K_END = 2 * ML_HEADS * ML_QK_DIM
ML_V_END = ML_K_END + ML_HEADS * ML_V_DIM
ML_I_END = ML_V_END + ML_HEADS
ML_F_END = ML_I_END + ML_HEADS
ML_IN_COLS = ML_F_END + D_MODEL

MLA_HEADS = 8
MLA_NOPE_DIM = 128
MLA_ROPE_DIM = 64
MLA_V_DIM = 128
MLA_KV_RANK = 256
MLA_Q_RANK = 384
ROPE_THETA = 10000.0
ATTN_BLOCK = 128

PEER_HEADS = 8
PEER_N_KEYS = 128
PEER_N_EXPERTS = PEER_N_KEYS * PEER_N_KEYS
PEER_KEY_DIM = 256
PEER_HALF = PEER_KEY_DIM // 2
PEER_TOPK = 16
PEER_BLOCK = 128

kernel_name = "yoco_mlstm_mla_peer_deepnorm"


def layer_norm(x, g, b):
    xf = x.astype(jnp.float32)
    mu = jnp.mean(xf, -1, keepdims=True)
    var = jnp.mean(jnp.square(xf - mu), -1, keepdims=True)
    y = (xf - mu) * lax.rsqrt(var + NORM_EPS)
    return (y * g.astype(jnp.float32) + b.astype(jnp.float32)).astype(x.dtype)


def rms_norm(x, g):
    xf = x.astype(jnp.float32)
    y = xf * lax.rsqrt(jnp.mean(jnp.square(xf), -1, keepdims=True) + NORM_EPS)
    return (y * g.astype(jnp.float32)).astype(x.dtype)


def rope_angles(positions, dim):
    inv_freq = ROPE_THETA ** (-jnp.arange(0, dim, 2, dtype=jnp.float32) / dim)
    ang = positions.astype(jnp.float32)[..., None] * inv_freq
    return jnp.cos(ang), jnp.sin(ang)


def apply_rope(x, cos, sin):
    xf = x.astype(jnp.float32)
    x1, x2 = jnp.split(xf, 2, axis=-1)
    return jnp.concatenate([x1 * cos - x2 * sin, x1 * sin + x2 * cos], -1).astype(x.dtype)


def mlstm_chunk_step(carry, inp):
    C, n, m = carry
    q, k, v, ig, lf = inp
    L = q.shape[2]
    b = jnp.cumsum(lf, axis=-1)
    causal = jnp.tril(jnp.ones((L, L), dtype=bool))
    log_w = jnp.where(causal, b[..., :, None] - b[..., None, :] + ig[..., None, :], -jnp.inf)
    log_inter = b + m[..., None]
    m_t = jnp.maximum(log_inter, jnp.max(log_w, -1))
    w = jnp.exp(log_w - m_t[..., None])
    s_inter = jnp.exp(log_inter - m_t)
    qk = jnp.einsum('bhtd,bhsd->bhts', q, k) * w
    num = jnp.einsum('bhts,bhsv->bhtv', qk, v) + s_inter[..., None] * jnp.einsum('bhtd,bhdv->bhtv', q, C)
    den = jnp.sum(qk, -1) + s_inter * jnp.einsum('bhtd,bhd->bht', q, n)
    h = num / jnp.maximum(jnp.abs(den), jnp.exp(-m_t))[..., None]
    b_last = b[..., -1]
    log_src = b_last[..., None] - b + ig
    m_new = jnp.maximum(b_last + m, jnp.max(log_src, -1))
    w_src = jnp.exp(log_src - m_new[..., None])
    s_old = jnp.exp(b_last + m - m_new)
    C_new = s_old[..., None, None] * C + jnp.einsum('bhs,bhsd,bhsv->bhdv', w_src, k, v)
    n_new = s_old[..., None] * n + jnp.einsum('bhs,bhsd->bhd', w_src, k)
    return (C_new, n_new, m_new), h


def mlstm_mixer(x, w_in, b_if, hn_g, w_out):
    B, S, _ = x.shape
    H, L = ML_HEADS, ML_CHUNK
    nc = S // L
    proj = x @ w_in
    q, k, v = proj[..., :ML_Q_END], proj[..., ML_Q_END:ML_K_END], proj[..., ML_K_END:ML_V_END]
    gi, gf, og = proj[..., ML_V_END:ML_I_END], proj[..., ML_I_END:ML_F_END], proj[..., ML_F_END:]

    def to_chunks(t, d):
        return t.reshape(B, nc, L, H, d).transpose(1, 0, 3, 2, 4).astype(jnp.float32)

    def gate_chunks(t):
        return t.reshape(B, nc, L, H).transpose(1, 0, 3, 2)

    qc = to_chunks(q, ML_QK_DIM)
    kc = to_chunks(k, ML_QK_DIM) * (ML_QK_DIM ** -0.5)
    vc = to_chunks(v, ML_V_DIM)
    b_if = b_if.astype(jnp.float32)
    ig = gate_chunks(gi.astype(jnp.float32) + b_if[0])
    lf = gate_chunks(jax.nn.log_sigmoid(gf.astype(jnp.float32) + b_if[1]))
    init = (jnp.zeros((B, H, ML_QK_DIM, ML_V_DIM), jnp.float32),
            jnp.zeros((B, H, ML_QK_DIM), jnp.float32),
            jnp.zeros((B, H), jnp.float32))
    _, h = lax.scan(mlstm_chunk_step, init, (qc, kc, vc, ig, lf))
    h = h.transpose(1, 0, 3, 2, 4).reshape(B, S, H, ML_V_DIM)
    mu = jnp.mean(h, -1, keepdims=True)
    var = jnp.mean(jnp.square(h - mu), -1, keepdims=True)
    hn = (h - mu) * lax.rsqrt(var + NORM_EPS) * hn_g.astype(jnp.float32).reshape(H, ML_V_DIM)
    out = jax.nn.sigmoid(og.astype(jnp.float32)) * hn.reshape(B, S, H * ML_V_DIM)
    return out.astype(x.dtype) @ w_out


def mla_shared_kv(xs, w_down, kv_norm_g, w_up, cos, sin):
    B, S, _ = xs.shape
    ckr = xs @ w_down
    c_kv = rms_norm(ckr[..., :MLA_KV_RANK], kv_norm_g)
    kv = (c_kv @ w_up).reshape(B, S, MLA_HEADS, MLA_NOPE_DIM + MLA_V_DIM)
    k_nope = kv[..., :MLA_NOPE_DIM].transpose(0, 2, 1, 3)
    v = kv[..., MLA_NOPE_DIM:].transpose(0, 2, 1, 3)
    k_rope = apply_rope(ckr[..., MLA_KV_RANK:], cos, sin)
    return k_nope, k_rope, v


def mla_mixer(x, w_dq, q_norm_g, w_uq, w_out, k_nope, k_rope, v, cos, sin):
    B, S, _ = x.shape
    H = MLA_HEADS
    c_q = rms_norm(x @ w_dq, q_norm_g)
    q = (c_q @ w_uq).reshape(B, S, H, MLA_NOPE_DIM + MLA_ROPE_DIM).transpose(0, 2, 1, 3)
    q_nope = q[..., :MLA_NOPE_DIM]
    q_rope = apply_rope(q[..., MLA_NOPE_DIM:], cos[:, None], sin[:, None])
    nb = S // ATTN_BLOCK

    def blocks(t):
        return t.reshape(B, H, nb, ATTN_BLOCK, t.shape[-1]).transpose(2, 0, 1, 3, 4)

    scale = (MLA_NOPE_DIM + MLA_ROPE_DIM) ** -0.5
    key_pos = jnp.arange(S)

    def attend(args):
        idx, qn, qr = args
        s = jnp.einsum('bhqd,bhkd->bhqk', qn, k_nope) + jnp.einsum('bhqd,bkd->bhqk', qr, k_rope)
        s = s.astype(jnp.float32) * scale
        q_pos = idx * ATTN_BLOCK + jnp.arange(ATTN_BLOCK)
        s = jnp.where(key_pos[None, :] <= q_pos[:, None], s, -jnp.inf)
        p = jax.nn.softmax(s, axis=-1).astype(v.dtype)
        return jnp.einsum('bhqk,bhkd->bhqd', p, v)

    o = lax.map(attend, (jnp.arange(nb), blocks(q_nope), blocks(q_rope)))
    o = o.transpose(1, 0, 3, 2, 4).reshape(B, S, H * MLA_V_DIM)
    return o @ w_out


def peer_ffn(x, w_q, sub_keys, u, v):
    B, S, D = x.shape
    T = B * S
    K = PEER_TOPK
    xt = x.reshape(T, D)
    q = (xt @ w_q).reshape(T, PEER_HEADS, 2, PEER_HALF)
    s = jnp.einsum('thcd,hcnd->thcn', q, sub_keys).astype(jnp.float32)
    s1, i1 = lax.top_k(s[:, :, 0], K)
    s2, i2 = lax.top_k(s[:, :, 1], K)
    cand_s = (s1[..., :, None] + s2[..., None, :]).reshape(T, PEER_HEADS, K * K)
    cand_i = (i1[..., :, None] * PEER_N_KEYS + i2[..., None, :]).reshape(T, PEER_HEADS, K * K)
    top_s, top_pos = lax.top_k(cand_s, K)
    expert_idx = jnp.take_along_axis(cand_i, top_pos, axis=-1)
    gates = jax.nn.softmax(top_s, axis=-1).astype(x.dtype)
    nb = T // PEER_BLOCK

    def expert_block(args):
        xb, eb, gb = args
        ub = jnp.take(u, eb, axis=0)
        act = jax.nn.gelu(jnp.einsum('thkd,td->thk', ub, xb), approximate=False)
        vb = jnp.take(v, eb, axis=0)
        return jnp.einsum('thk,thkd->td', gb * act, vb)

    out = lax.map(expert_block, (xt.reshape(nb, PEER_BLOCK, D),
                                 expert_idx.reshape(nb, PEER_BLOCK, PEER_HEADS, K),
                                 gates.reshape(nb, PEER_BLOCK, PEER_HEADS, K)))
    return out.reshape(B, S, D)


def setup_inputs(seed: int = 0) -> dict:
    key = jax.random.key(seed)
    ks = jax.random.split(key, 24)
    D = D_MODEL
    nrm = jax.random.normal
    f32 = jnp.float32
    x = nrm(ks[0], (BATCH, SEQ, D), f32)
    p = nrm(ks[1], (DEPTH, BATCH, SEQ, PLE_DIM), f32)
    positions = jnp.broadcast_to(jnp.arange(SEQ, dtype=jnp.int32), (BATCH, SEQ))
    ln_g = 1.0 + 0.05 * nrm(ks[2], (DEPTH, 2, D), f32)
    ln_b = 0.02 * nrm(ks[3], (DEPTH, 2, D), f32)
    a_w_in = nrm(ks[4], (N_A_LAYERS, D, ML_IN_COLS), f32) * D ** -0.5
    b_i = 0.1 * nrm(ks[5], (N_A_LAYERS, ML_HEADS), f32)
    b_f = jnp.linspace(3.0, 6.0, ML_HEADS, dtype=f32) + 0.1 * nrm(ks[6], (N_A_LAYERS, ML_HEADS), f32)
    a_b_if = jnp.stack([b_i, b_f], axis=1)
    a_hn_g = 1.0 + 0.05 * nrm(ks[7], (N_A_LAYERS, D), f32)
    a_w_out = nrm(ks[8], (N_A_LAYERS, D, D), f32) * (D ** -0.5 * DN_BETA)
    kv_w_down = nrm(ks[9], (D, MLA_KV_RANK + MLA_ROPE_DIM), f32) * D ** -0.5
    kv_norm_g = 1.0 + 0.05 * nrm(ks[10], (MLA_KV_RANK,), f32)
    kv_w_up = nrm(ks[11], (MLA_KV_RANK, MLA_HEADS * (MLA_NOPE_DIM + MLA_V_DIM)), f32) * MLA_KV_RANK ** -0.5
    b_w_dq = nrm(ks[12], (N_B_LAYERS, D, MLA_Q_RANK), f32) * D ** -0.5
    b_q_norm_g = 1.0 + 0.05 * nrm(ks[13], (N_B_LAYERS, MLA_Q_RANK), f32)
    b_w_uq = nrm(ks[14], (N_B_LAYERS, MLA_Q_RANK, MLA_HEADS * (MLA_NOPE_DIM + MLA_ROPE_DIM)), f32) * MLA_Q_RANK ** -0.5
    b_w_out = nrm(ks[15], (N_B_LAYERS, MLA_HEADS * MLA_V_DIM, D), f32) * ((MLA_HEADS * MLA_V_DIM) ** -0.5 * DN_BETA)
    peer_w_q = nrm(ks[16], (DEPTH, D, PEER_HEADS * PEER_KEY_DIM), f32) * D ** -0.5
    peer_sub_keys = nrm(ks[17], (DEPTH, PEER_HEADS, 2, PEER_N_KEYS, PEER_HALF), f32) * PEER_HALF ** -0.5
    peer_u = nrm(ks[18], (DEPTH, PEER_N_EXPERTS, D), f32) * D ** -0.5
    peer_v = nrm(ks[19], (DEPTH, PEER_N_EXPERTS, D), f32) * (DN_BETA * PEER_HEADS ** -0.5)
    ple_w_proj = nrm(ks[20], (DEPTH, PLE_DIM, D), f32) * (0.5 * PLE_DIM ** -0.5)
    ple_w_gate = nrm(ks[21], (DEPTH, D, D), f32) * D ** -0.5
    return {"x": x, "p": p, "positions": positions, "ln_g": ln_g, "ln_b": ln_b,
            "a_w_in": a_w_in, "a_b_if": a_b_if, "a_hn_g": a_hn_g, "a_w_out": a_w_out,
            "kv_w_down": kv_w_down, "kv_norm_g": kv_norm_g, "kv_w_up": kv_w_up,
            "b_w_dq": b_w_dq, "b_q_norm_g": b_q_norm_g, "b_w_uq": b_w_uq, "b_w_out": b_w_out,
            "peer_w_q": peer_w_q, "peer_sub_keys": peer_sub_keys, "peer_u": peer_u, "peer_v": peer_v,
            "ple_w_proj": ple_w_proj, "ple_w_gate": ple_w_gate}


def reference(x, p, positions, ln_g, ln_b, a_w_in, a_b_if, a_hn_g, a_w_out,
              kv_w_down, kv_norm_g, kv_w_up, b_w_dq, b_q_norm_g, b_w_uq, b_w_out,
              peer_w_q, peer_sub_keys, peer_u, peer_v, ple_w_proj, ple_w_gate):
    cos, sin = rope_angles(positions, MLA_ROPE_DIM)
    shared = None
    for i in range(DEPTH):
        if i < N_A_LAYERS:
            mix = mlstm_mixer(x, a_w_in[i], a_b_if[i], a_hn_g[i], a_w_out[i])
        else:
            j = i - N_A_LAYERS
            if j == 0:
                shared = mla_shared_kv(x, kv_w_down, kv_norm_g, kv_w_up, cos, sin)
            k_nope, k_rope, v = shared
            mix = mla_mixer(x, b_w_dq[j], b_q_norm_g[j], b_w_uq[j], b_w_out[j],
                            k_nope, k_rope, v, cos, sin)
        x = layer_norm(DN_ALPHA * x + mix, ln_g[i, 0], ln_b[i, 0])
        x = layer_norm(DN_ALPHA * x + peer_ffn(x, peer_w_q[i], peer_sub_keys[i], peer_u[i], peer_v[i]),
                       ln_g[i, 1], ln_b[i, 1])
        x = x + jax.nn.sigmoid(x @ ple_w_gate[i]) * (p[i] @ ple_w_proj[i])
    return x
```

```cpp
#include <hip/hip_runtime.h>
#include <hip/hip_cooperative_groups.h>
#include <stdint.h>
#include <cstdio>
namespace cg = cooperative_groups;

#ifndef MEGA
#define MEGA 1
#endif

#define DI __device__ __forceinline__
typedef unsigned short u16;
typedef short bf16x8 __attribute__((ext_vector_type(8)));
typedef short s16x4 __attribute__((ext_vector_type(4)));
typedef float f32x4 __attribute__((ext_vector_type(4)));
typedef float f32x16 __attribute__((ext_vector_type(16)));
typedef float f32x2 __attribute__((ext_vector_type(2)));
typedef unsigned u32x4 __attribute__((ext_vector_type(4)));
typedef unsigned u32x2 __attribute__((ext_vector_type(2)));
typedef int i32x4 __attribute__((ext_vector_type(4)));
typedef unsigned char u8;
typedef __bf16 bf2_t __attribute__((ext_vector_type(2)));

constexpr int S = 16384;
constexpr int D = 1024;
constexpr float NORM_EPS = 1e-5f;
constexpr float DN_ALPHA = 1.41421356237309515f;
constexpr int SMEM_BYTES = 73728;
constexpr int NPHASE = 20;

struct Params {
  const float *x, *p; const int* pos;
  const float *ln_g, *ln_b, *a_w_in, *a_b_if, *a_hn_g, *a_w_out, *kv_w_down, *kv_norm_g, *kv_w_up,
      *b_w_dq, *b_q_norm_g, *b_w_uq, *b_w_out, *peer_w_q, *peer_sub_keys, *peer_u, *peer_v, *ple_w_proj, *ple_w_gate;
  float* out;
  u16 *WinT, *WoaT, *WpqT, *SubK, *WgT, *WpT, *WdT, *WupT, *WuqT, *WobT, *pb;
  u8 *Uq, *Vq; float *scU, *scV;
  u8 *Xq8, *Wq8, *Wg8, *Win8; float *sxq, *swq, *swg, *swin;
  float *F1, *F2;
  u16 *B0, *B1, *B2, *B3, *B4, *B6;
  float *igf, *lf, *dn, *nprev, *blast, *mloc, *mprev, *ropec, *ropes;
  u16 *ckvb, *cqb, *krope;
  unsigned* bar;
};

DI int opaque_tid() { int t = threadIdx.x; asm volatile("" : "+v"(t)); return t; }
DI int opaque_bid() { int b = blockIdx.x; asm volatile("" : "+s"(b)); return b; }
#define TIDX opaque_tid()
#define BIDX opaque_bid()
DI unsigned pack2(float a, float b) { f32x2 v = {a, b}; bf2_t r = __builtin_convertvector(v, bf2_t); return __builtin_bit_cast(unsigned, r); }
DI u16 f2bf(float a) { return (u16)(pack2(a, 0.f) & 0xffffu); }
DI float bflo(unsigned u) { return __uint_as_float(u << 16); }
DI float bfhi(unsigned u) { return __uint_as_float(u & 0xffff0000u); }
DI float bf2f(u16 v) { return __uint_as_float(((unsigned)v) << 16); }
DI f32x4 mfma16(bf16x8 a, bf16x8 b, f32x4 c) { return __builtin_amdgcn_mfma_f32_16x16x32_bf16(a, b, c, 0, 0, 0); }
DI f32x16 mfma32(bf16x8 a, bf16x8 b, f32x16 c) { return __builtin_amdgcn_mfma_f32_32x32x16_bf16(a, b, c, 0, 0, 0); }
DI int crow(int i, int hh) { return (i & 3) + 8 * (i >> 2) + 4 * hh; }
DI float wave_sum(float v) {
#pragma unroll
  for (int o = 32; o; o >>= 1) v += __shfl_xor(v, o);
  return v;
}
DI float wave_max(float v) {
#pragma unroll
  for (int o = 32; o; o >>= 1) v = fmaxf(v, __shfl_xor(v, o));
  return v;
}
DI float wave_sum_fast(float v) {
  v += __int_as_float(__builtin_amdgcn_update_dpp(0, __float_as_int(v), 0xB1, 0xf, 0xf, true));
  v += __int_as_float(__builtin_amdgcn_update_dpp(0, __float_as_int(v), 0x4E, 0xf, 0xf, true));
  v += __int_as_float(__builtin_amdgcn_update_dpp(0, __float_as_int(v), 0x141, 0xf, 0xf, true));
  v += __int_as_float(__builtin_amdgcn_update_dpp(0, __float_as_int(v), 0x140, 0xf, 0xf, true));
  { const auto sw = __builtin_amdgcn_permlane16_swap(__float_as_uint(v), __float_as_uint(v), false, false); v = __uint_as_float(sw[0]) + __uint_as_float(sw[1]); }
  { const auto sw = __builtin_amdgcn_permlane32_swap(__float_as_uint(v), __float_as_uint(v), false, false); v = __uint_as_float(sw[0]) + __uint_as_float(sw[1]); }
  return v;
}
DI float sigmoidf_(float x) { return 1.f / (1.f + __expf(-x)); }
DI float logsigmoidf_(float x) { return fminf(x, 0.f) - log1pf(__expf(-fabsf(x))); }
DI bf16x8 pack8(float a0, float a1, float a2, float a3, float a4, float a5, float a6, float a7) {
  uint4 u; u.x = pack2(a0, a1); u.y = pack2(a2, a3); u.z = pack2(a4, a5); u.w = pack2(a6, a7);
  return __builtin_bit_cast(bf16x8, u);
}

DI void tconv_tile(const float* __restrict__ src, int lds, int K, int c0, int nc, u16* __restrict__ dst, int r0,
                   const float* __restrict__ g, float sc, int ti, char* smem) {
  float (*t)[65] = (float (*)[65])smem;
  const int tid = TIDX;
  const int nct = (nc + 63) / 64;
  const int kt = ti / nct, ct = ti % nct;
  __syncthreads();
#pragma unroll
  for (int r = 0; r < 16; ++r) {
    const int k = r * 4 + (tid >> 6), n = tid & 63;
    const int col = ct * 64 + n;
    float v = 0.f;
    if (col < nc) v = src[(size_t)(kt * 64 + k) * lds + c0 + col];
    if (g) v *= g[kt * 64 + k];
    t[k][n] = v * sc;
  }
  __syncthreads();
#pragma unroll
  for (int r = 0; r < 16; ++r) {
    const int n = r * 4 + (tid >> 6), k = tid & 63;
    const int col = ct * 64 + n;
    if (col < nc) dst[(size_t)(r0 + col) * K + kt * 64 + k] = f2bf(t[k][n]);
  }
}
DI void cvt_job(const float* __restrict__ src, u16* __restrict__ dst, size_t n) {
  const size_t n4 = n >> 2;
  const size_t stride = (size_t)gridDim.x * 256;
  for (size_t i = (size_t)BIDX * 256 + TIDX; i < n4; i += stride * 8) {
    float4 v[8];
#pragma unroll
    for (int u = 0; u < 8; ++u) if (i + u * stride < n4) { const f32x4 t_ = __builtin_nontemporal_load((const f32x4*)src + i + u * stride); v[u] = make_float4(t_[0], t_[1], t_[2], t_[3]); }
#pragma unroll
    for (int u = 0; u < 8; ++u) if (i + u * stride < n4) {
      uint2 o; o.x = pack2(v[u].x, v[u].y); o.y = pack2(v[u].z, v[u].w);
      ((uint2*)dst)[i + u * stride] = o;
    }
  }
}
DI void zero_job(u16* __restrict__ dst, size_t n) {
  for (size_t i = (size_t)BIDX * 256 + TIDX; i < n; i += (size_t)gridDim.x * 256) dst[i] = 0;
}

DI unsigned q8(float v, float inv, int bias) { int q = (int)rintf(v * inv); q = q < -127 ? -127 : (q > 127 ? 127 : q); return (unsigned)(q + bias) & 0xffu; }
DI unsigned q8x4(float4 v, float inv, int bias) { return q8(v.x, inv, bias) | (q8(v.y, inv, bias) << 8) | (q8(v.z, inv, bias) << 16) | (q8(v.w, inv, bias) << 24); }
DI float absmax4(float4 v) { return fmaxf(fmaxf(fabsf(v.x), fabsf(v.y)), fmaxf(fabsf(v.z), fabsf(v.w))); }
DI void quant_rows(const float* __restrict__ src, u8* __restrict__ dst, float* __restrict__ scale, int nrows, int bias, int vb, int nvb) {
  const int lane = TIDX & 63, wave = TIDX >> 6;
  for (int row0 = vb * 4 + wave; row0 < nrows; row0 += nvb * 16) {
    float4 v[4][4];
#pragma unroll
    for (int u = 0; u < 4; ++u) {
      const int row = row0 + u * nvb * 4;
      if (row < nrows) {
        const f32x4* r = (const f32x4*)(src + (size_t)row * 1024 + lane * 16);
#pragma unroll
        for (int k = 0; k < 4; ++k) { const f32x4 t_ = __builtin_nontemporal_load(r + k); v[u][k] = make_float4(t_[0], t_[1], t_[2], t_[3]); }
      }
    }
#pragma unroll
    for (int u = 0; u < 4; ++u) {
      const int row = row0 + u * nvb * 4;
      if (row < nrows) {
        float mx = fmaxf(fmaxf(absmax4(v[u][0]), absmax4(v[u][1])), fmaxf(absmax4(v[u][2]), absmax4(v[u][3])));
        mx = wave_max(mx);
        const float sc = mx > 0.f ? mx * (1.f / 127.f) : 1.f;
        const float inv = 1.f / sc;
        u32x4 o; o[0] = q8x4(v[u][0], inv, bias); o[1] = q8x4(v[u][1], inv, bias); o[2] = q8x4(v[u][2], inv, bias); o[3] = q8x4(v[u][3], inv, bias);
        *(u32x4*)(dst + (size_t)row * 1024 + lane * 16) = o;
        if (lane == 0) scale[row] = sc;
      }
    }
  }
}

DI void wq_tile(const float* __restrict__ src, int lds, int c0, u8* __restrict__ dst, float* __restrict__ scale, int r0, float mult, int ti, char* smem) {
  float (*t)[17] = (float (*)[17])smem;
  float* red = (float*)(smem + 1024 * 17 * 4);
  const int tid = TIDX;
  const int n = tid & 15, kq = tid >> 4;
  __syncthreads();
  float mx = 0.f;
#pragma unroll 8
  for (int kk = 0; kk < 64; ++kk) {
    const int k = kk * 16 + kq;
    const float v = src[(size_t)k * lds + c0 + ti * 16 + n];
    t[k][n] = v;
    mx = fmaxf(mx, fabsf(v));
  }
  red[kq * 16 + n] = mx;
  __syncthreads();
  if (tid < 16) {
    float m2 = 0.f;
#pragma unroll
    for (int j = 0; j < 16; ++j) m2 = fmaxf(m2, red[j * 16 + tid]);
    const float sc = m2 > 0.f ? m2 * (1.f / 127.f) : 1.f;
    red[256 + tid] = 1.f / sc;
    scale[r0 + ti * 16 + tid] = sc * mult;
  }
  __syncthreads();
  {
    const int nn = tid >> 4, ks = (tid & 15) * 64;
    const float inv = red[256 + nn];
    u8* d = dst + (size_t)(r0 + ti * 16 + nn) * 1024 + ks;
#pragma unroll
    for (int j = 0; j < 4; ++j) {
      u32x4 o;
#pragma unroll
      for (int w = 0; w < 4; ++w) {
        const int k = ks + j * 16 + w * 4;
        o[w] = q8(t[k][nn], inv, 0) | (q8(t[k + 1][nn], inv, 0) << 8) | (q8(t[k + 2][nn], inv, 0) << 16) | (q8(t[k + 3][nn], inv, 0) << 24);
      }
      *(u32x4*)(d + j * 16) = o;
    }
  }
}

DI void quant_rows_bf16(const u16* __restrict__ src, u8* __restrict__ dst, float* __restrict__ scale, int nrows, int vb, int nvb) {
  const int lane = TIDX & 63, wave = TIDX >> 6;
  for (int row = vb * 4 + wave; row < nrows; row += nvb * 4) {
    const uint4 a = *(const uint4*)(src + (size_t)row * 1024 + lane * 16), b = *(const uint4*)(src + (size_t)row * 1024 + lane * 16 + 8);
    const float4 v0 = make_float4(bflo(a.x), bfhi(a.x), bflo(a.y), bfhi(a.y)), v1 = make_float4(bflo(a.z), bfhi(a.z), bflo(a.w), bfhi(a.w));
    const float4 v2 = make_float4(bflo(b.x), bfhi(b.x), bflo(b.y), bfhi(b.y)), v3 = make_float4(bflo(b.z), bfhi(b.z), bflo(b.w), bfhi(b.w));
    float mx = fmaxf(fmaxf(absmax4(v0), absmax4(v1)), fmaxf(absmax4(v2), absmax4(v3)));
    mx = wave_max(mx);
    const float sc = mx > 0.f ? mx * (1.f / 127.f) : 1.f;
    const float inv = 1.f / sc;
    u32x4 o; o[0] = q8x4(v0, inv, 0); o[1] = q8x4(v1, inv, 0); o[2] = q8x4(v2, inv, 0); o[3] = q8x4(v3, inv, 0);
    *(u32x4*)(dst + (size_t)row * 1024 + lane * 16) = o;
    if (lane == 0) scale[row] = sc;
  }
}

DI void phase_prologue(const Params& p, char* smem) {
#define TJOB(src, lds, K, c0, nc, dst, r0, g, sc) { const int nt__ = (((nc) + 63) / 64) * ((K) / 64); \
    if (ti >= base && ti < base + nt__) tconv_tile(src, lds, K, c0, nc, dst, r0, g, sc, ti - base, smem); base += nt__; }
  for (int ti = BIDX;; ti += gridDim.x) {
    int base = 0;
#define WJOB(c0, nc, r0, mult) { const int nt__ = (nc) / 16; \
    if (ti >= base && ti < base + nt__) wq_tile(p.a_w_in, 3088, c0, p.Win8, p.swin, r0, mult, ti - base, smem); base += nt__; }
    WJOB(0, 512, 0, 1.f)
    WJOB(512, 512, 512, 0.125f)
    WJOB(1024, 1024, 1024, 1.f)
    WJOB(2064, 1024, 2048, 1.f)
    WJOB(2048, 16, 3072, 1.f)
#undef WJOB
    TJOB(p.a_w_out, 1024, 1024, 0, 1024, p.WoaT, 0, nullptr, 1.f)
    TJOB(p.peer_w_q, 2048, 1024, 0, 2048, p.WpqT, 0, nullptr, 1.f)
    TJOB(p.peer_w_q + (size_t)1024 * 2048, 2048, 1024, 0, 2048, p.WpqT + (size_t)2048 * 1024, 0, nullptr, 1.f)
    TJOB(p.ple_w_gate, 1024, 1024, 0, 1024, p.WgT, 0, nullptr, 1.f)
    TJOB(p.ple_w_gate + (size_t)1024 * 1024, 1024, 1024, 0, 1024, p.WgT + (size_t)1024 * 1024, 0, nullptr, 1.f)
    TJOB(p.ple_w_proj, 1024, 256, 0, 1024, p.WpT, 0, nullptr, 1.f)
    TJOB(p.ple_w_proj + (size_t)256 * 1024, 1024, 256, 0, 1024, p.WpT + (size_t)1024 * 256, 0, nullptr, 1.f)
    TJOB(p.kv_w_down, 320, 1024, 0, 256, p.WdT, 0, nullptr, 1.f)
    TJOB(p.b_w_dq, 384, 1024, 0, 384, p.WdT, 256, nullptr, 1.f)
    TJOB(p.kv_w_down, 320, 1024, 256, 64, p.WdT, 640, nullptr, 1.f)
    TJOB(p.kv_w_up, 2048, 256, 0, 2048, p.WupT, 0, p.kv_norm_g, 1.f)
    TJOB(p.b_w_uq, 1536, 384, 0, 1536, p.WuqT, 0, p.b_q_norm_g, 0.07216878364870322f * 1.4426950408889634f)
    TJOB(p.b_w_out, 1024, 1024, 0, 1024, p.WobT, 0, nullptr, 1.f)
    if (ti >= base) break;
  }
#undef TJOB
  zero_job((u16*)(p.Win8 + (size_t)3088 * 1024), (size_t)112 * 512);
  for (int i = BIDX * 256 + TIDX; i < 112; i += gridDim.x * 256) p.swin[3088 + i] = 0.f;
  zero_job(p.WdT + (size_t)704 * 1024, (size_t)64 * 1024);
  cvt_job(p.peer_sub_keys, p.SubK, (size_t)2 * 8 * 2 * 128 * 128);
  quant_rows(p.x, p.Xq8, p.sxq, S, 0, BIDX, gridDim.x);
  cvt_job(p.p, p.pb, (size_t)2 * S * 256);
  for (int i = BIDX * 256 + TIDX; i < S * 32; i += gridDim.x * 256) {
    const int m = i >> 5, f = i & 31;
    const float invf = powf(10000.f, -(float)(2 * f) / 64.f);
    const float ang = (float)p.pos[m] * invf;
    const double a = (double)ang;
    const double n = rint(a * 0.63661977236758134308);
    double r = fma(-n, 1.57079632679489655800, a);
    r = fma(-n, 6.12323399573676603587e-17, r);
    const double r2 = r * r;
    double sn = r * (1.0 + r2 * (-1.0 / 6 + r2 * (1.0 / 120 + r2 * (-1.0 / 5040 + r2 * (1.0 / 362880 + r2 * (-1.0 / 39916800 + r2 * (1.0 / 6227020800.0)))))));
    double cs = 1.0 + r2 * (-0.5 + r2 * (1.0 / 24 + r2 * (-1.0 / 720 + r2 * (1.0 / 40320 + r2 * (-1.0 / 3628800 + r2 * (1.0 / 479001600.0 + r2 * (-1.0 / 87178291200.0)))))));
    const int q = ((int)n) & 3;
    double c2, s2;
    if (q == 0) { c2 = cs; s2 = sn; } else if (q == 1) { c2 = -sn; s2 = cs; } else if (q == 2) { c2 = -cs; s2 = -sn; } else { c2 = sn; s2 = -cs; }
    p.ropec[i] = (float)c2; p.ropes[i] = (float)s2;
  }
}

#define GLDS16(src, dst) __builtin_amdgcn_global_load_lds((const unsigned*)(src), (__attribute__((address_space(3))) unsigned*)(dst), 16, 0, 0)
DI void gemm_core(const u16* __restrict__ P, int ldp, const u16* __restrict__ Q, int ldq, int K, int p0, int q0,
                  char* smem, f32x4 (&acc)[4][4]) {
  const int tid = TIDX, lane = tid & 63, wave = tid >> 6;
  const int wp = wave >> 1, wq = wave & 1;
  const u16* pu = P + (size_t)p0 * ldp;
  const u16* qu = Q + (size_t)q0 * ldq;
  int offp[4], offq[4];
#pragma unroll
  for (int i = 0; i < 4; ++i) {
    const int row = wave * 32 + i * 8 + (lane >> 3);
    const int g = (lane & 7) ^ ((row >> 1) & 7);
    offp[i] = row * ldp + g * 8;
    offq[i] = row * ldq + g * 8;
  }
  const int swz = (lane & 15) >> 1;
  const int ra_base = (wp * 64 + (lane & 15)) * 128, rb_base = 16384 + (wq * 64 + (lane & 15)) * 128;
  const int KT = K >> 6;
  __syncthreads();
#pragma unroll
  for (int i = 0; i < 4; ++i) {
    GLDS16(pu + offp[i], smem + (wave * 4 + i) * 1024);
    GLDS16(qu + offq[i], smem + 16384 + (wave * 4 + i) * 1024);
  }
  for (int kt = 0; kt < KT; ++kt) {
    asm volatile("s_waitcnt vmcnt(0)" ::: "memory");
    __syncthreads();
    if (kt + 1 < KT) {
      char* sn = smem + ((kt + 1) & 1) * 32768;
#pragma unroll
      for (int i = 0; i < 4; ++i) {
        GLDS16(pu + (kt + 1) * 64 + offp[i], sn + (wave * 4 + i) * 1024);
        GLDS16(qu + (kt + 1) * 64 + offq[i], sn + 16384 + (wave * 4 + i) * 1024);
      }
    }
    const char* sc = smem + (kt & 1) * 32768;
#pragma unroll
    for (int ks = 0; ks < 2; ++ks) {
      bf16x8 fa[4], fb[4];
      const int gofs = ((ks * 4 + (lane >> 4)) ^ swz) * 16;
#pragma unroll
      for (int mt = 0; mt < 4; ++mt) fa[mt] = *(const bf16x8*)(sc + ra_base + mt * 2048 + gofs);
#pragma unroll
      for (int nt = 0; nt < 4; ++nt) fb[nt] = *(const bf16x8*)(sc + rb_base + nt * 2048 + gofs);
#pragma unroll
      for (int mt = 0; mt < 4; ++mt)
#pragma unroll
        for (int nt = 0; nt < 4; ++nt) acc[mt][nt] = mfma16(fa[mt], fb[nt], acc[mt][nt]);
    }
  }
  __syncthreads();
}
typedef int i32x4_t __attribute__((ext_vector_type(4)));
DI void gemm_core_i8(const u8* __restrict__ P, int ldp, const u8* __restrict__ Q, int ldq, int K, int p0, int q0,
                     char* smem, i32x4_t (&acc)[4][4]) {
  const int tid = TIDX, lane = tid & 63, wave = tid >> 6;
  const int wp = wave >> 1, wq = wave & 1;
  const u8* pu = P + (size_t)p0 * ldp;
  const u8* qu = Q + (size_t)q0 * ldq;
  int offp[4], offq[4];
#pragma unroll
  for (int i = 0; i < 4; ++i) {
    const int row = wave * 32 + i * 8 + (lane >> 3);
    const int g = (lane & 7) ^ ((row >> 1) & 7);
    offp[i] = row * ldp + g * 16;
    offq[i] = row * ldq + g * 16;
  }
  const int swz = (lane & 15) >> 1;
  const int ra_base = (wp * 64 + (lane & 15)) * 128, rb_base = 16384 + (wq * 64 + (lane & 15)) * 128;
  const int KT = K >> 7;
  __syncthreads();
#pragma unroll
  for (int i = 0; i < 4; ++i) {
    GLDS16(pu + offp[i], smem + (wave * 4 + i) * 1024);
    GLDS16(qu + offq[i], smem + 16384 + (wave * 4 + i) * 1024);
  }
  for (int kt = 0; kt < KT; ++kt) {
    asm volatile("s_waitcnt vmcnt(0)" ::: "memory");
    __syncthreads();
    if (kt + 1 < KT) {
      char* sn = smem + ((kt + 1) & 1) * 32768;
#pragma unroll
      for (int i = 0; i < 4; ++i) {
        GLDS16(pu + (kt + 1) * 128 + offp[i], sn + (wave * 4 + i) * 1024);
        GLDS16(qu + (kt + 1) * 128 + offq[i], sn + 16384 + (wave * 4 + i) * 1024);
      }
    }
    const char* sc = smem + (kt & 1) * 32768;
#pragma unroll
    for (int ks = 0; ks < 2; ++ks) {
      i32x4_t fa[4], fb[4];
      const int gofs = ((ks * 4 + (lane >> 4)) ^ swz) * 16;
#pragma unroll
      for (int mt = 0; mt < 4; ++mt) fa[mt] = *(const i32x4_t*)(sc + ra_base + mt * 2048 + gofs);
#pragma unroll
      for (int nt = 0; nt < 4; ++nt) fb[nt] = *(const i32x4_t*)(sc + rb_base + nt * 2048 + gofs);
#pragma unroll
      for (int mt = 0; mt < 4; ++mt)
#pragma unroll
        for (int nt = 0; nt < 4; ++nt) acc[mt][nt] = __builtin_amdgcn_mfma_i32_16x16x64_i8(fa[mt], fb[nt], acc[mt][nt], 0, 0, 0);
    }
  }
  __syncthreads();
}
DI void zero_acc(f32x4 (&acc)[4][4]) {
#pragma unroll
  for (int a = 0; a < 4; ++a)
#pragma unroll
    for (int b = 0; b < 4; ++b) acc[a][b] = f32x4{0.f, 0.f, 0.f, 0.f};
}
#define EPI_IDX                                                        \
  const int lane = TIDX & 63, wave = TIDX >> 6;          \
  const int pb_ = p0 + (wave >> 1) * 64 + (lane >> 4) * 4;             \
  const int qb_ = q0 + (wave & 1) * 64 + (lane & 15);

DI void store4bf(u16* dst, float a, float b, float c, float d) { uint2 o; o.x = pack2(a, b); o.y = pack2(c, d); *(uint2*)dst = o; }

DI void stage_acc(f32x4 (&acc)[4][4], char* smem) {
  const int t = TIDX, lane = t & 63, wave = t >> 6;
  float* st = (float*)smem;
  const int pl = (wave >> 1) * 64 + (lane >> 4) * 4, ql = (wave & 1) * 64 + (lane & 15);
#pragma unroll
  for (int a = 0; a < 4; ++a)
#pragma unroll
    for (int b = 0; b < 4; ++b) *(f32x4*)(st + (ql + b * 16) * 132 + pl + a * 16) = acc[a][b];
}
#define EPI_BEGIN                                                                                  \
  stage_acc(acc, smem);                                                                            \
  __syncthreads();                                                                                 \
  {                                                                                                \
    const int et_ = TIDX;                                                                          \
    _Pragma("unroll 4") for (int ej_ = 0; ej_ < 16; ++ej_) {                                       \
      const int er_ = (et_ >> 5) + 8 * ej_, ec_ = (et_ & 31) * 4;                                  \
      const f32x4 ev_ = *(const f32x4*)((const float*)smem + er_ * 132 + ec_);                     \
      const int pb_ = p0 + ec_, qb_ = q0 + er_;
#define EPI_END }}

struct TileIter { int band, j, G, MTB; };
DI TileIter tile_iter_init() {
  TileIter t;
  if ((gridDim.x & 7) == 0) { t.band = BIDX & 7; t.j = BIDX >> 3; t.G = gridDim.x >> 3; t.MTB = 16; }
  else { t.band = 0; t.j = BIDX; t.G = gridDim.x; t.MTB = 128; }
  return t;
}
DI bool tile_of(const TileIter& t, int q, int NT, int& mt, int& nt) {
  const int full = NT >> 3, rem = NT & 7;
  const int per_full = t.MTB * 8;
  const int ng = q / per_full;
  if (ng < full) {
    const int r = q - ng * per_full, mh = r >> 6, r2 = r & 63;
    nt = ng * 8 + (r2 >> 3); mt = t.band * t.MTB + mh * 8 + (r2 & 7);
    return true;
  }
  q -= full * per_full;
  if (rem == 0 || q >= t.MTB * rem) return false;
  nt = full * 8 + q % rem; mt = t.band * t.MTB + q / rem;
  return true;
}
#define TILE_LOOP(NT) const TileIter tit_ = tile_iter_init(); int mt_, nt_; for (int q_ = tit_.j; tile_of(tit_, q_, (NT), mt_, nt_); q_ += tit_.G)


DI void gemm_core2(const u16* __restrict__ P, int ldp, const u16* __restrict__ Q, int ldq, int K, int p0, int q0,
                   char* smem, f32x4 (&acc)[4][8]) {
  const int tid = TIDX, lane = tid & 63, wave = tid >> 6;
  const int wp = wave >> 1, wq = wave & 1;
  const u16* pu = P + (size_t)p0 * ldp;
  const u16* qu = Q + (size_t)q0 * ldq;
  const int gd = (lane & 3) ^ ((lane >> 4) & 3);
  int offp[2], offq[4];
#pragma unroll
  for (int i = 0; i < 2; ++i) offp[i] = ((wave * 2 + i) * 16 + (lane >> 2)) * ldp + gd * 8;
#pragma unroll
  for (int i = 0; i < 4; ++i) offq[i] = ((wave * 4 + i) * 16 + (lane >> 2)) * ldq + gd * 8;
  const int pos16 = ((lane >> 4) ^ ((lane >> 2) & 3)) * 16;
  const int ra_base = (wp * 64 + (lane & 15)) * 64 + pos16, rb_base = 8192 + (wq * 128 + (lane & 15)) * 64 + pos16;
  const int KT = K >> 5;
  auto issue = [&](int kt, int st) {
    char* sn = smem + st * 24576;
#pragma unroll
    for (int i = 0; i < 2; ++i) GLDS16(pu + kt * 32 + offp[i], sn + (wave * 2 + i) * 1024);
#pragma unroll
    for (int i = 0; i < 4; ++i) GLDS16(qu + kt * 32 + offq[i], sn + 8192 + (wave * 4 + i) * 1024);
  };
  __syncthreads();
  issue(0, 0); issue(1, 1);
  int st = 0;
  for (int kt = 0; kt < KT; ++kt) {
    if (kt + 1 < KT) asm volatile("s_waitcnt vmcnt(6)" ::: "memory");
    else asm volatile("s_waitcnt vmcnt(0)" ::: "memory");
    asm volatile("s_waitcnt lgkmcnt(0)" ::: "memory");
    __builtin_amdgcn_s_barrier();
    if (kt + 2 < KT) issue(kt + 2, st >= 1 ? st - 1 : 2);
    const char* sc = smem + st * 24576;
    bf16x8 fa[4], fb[8];
#pragma unroll
    for (int mt = 0; mt < 4; ++mt) fa[mt] = *(const bf16x8*)(sc + ra_base + mt * 1024);
#pragma unroll
    for (int nt = 0; nt < 8; ++nt) fb[nt] = *(const bf16x8*)(sc + rb_base + nt * 1024);
#pragma unroll
    for (int mt = 0; mt < 4; ++mt)
#pragma unroll
      for (int nt = 0; nt < 8; ++nt) acc[mt][nt] = mfma16(fa[mt], fb[nt], acc[mt][nt]);
    st = (st == 2) ? 0 : st + 1;
  }
  __syncthreads();
}
DI void zero_acc2(f32x4 (&acc)[4][8]) {
#pragma unroll
  for (int a = 0; a < 4; ++a)
#pragma unroll
    for (int b = 0; b < 8; ++b) acc[a][b] = f32x4{0.f, 0.f, 0.f, 0.f};
}
DI void stage_acc2(f32x4 (&acc)[4][8], char* smem, int half) {
  const int t = TIDX, lane = t & 63, wave = t >> 6;
  if ((wave & 1) != half) return;
  float* st = (float*)smem;
  const int pl = (wave >> 1) * 64 + (lane >> 4) * 4, ql = (lane & 15);
#pragma unroll
  for (int a = 0; a < 4; ++a)
#pragma unroll
    for (int b = 0; b < 8; ++b) *(f32x4*)(st + (ql + b * 16) * 132 + pl + a * 16) = acc[a][b];
}
#define EPI2_BEGIN                                                                                 \
  for (int eh_ = 0; eh_ < 2; ++eh_) {                                                              \
    __syncthreads();                                                                               \
    stage_acc2(acc, smem, eh_);                                                                    \
    __syncthreads();                                                                               \
    const int et_ = TIDX;                                                                          \
    _Pragma("unroll 4") for (int ej_ = 0; ej_ < 16; ++ej_) {                                       \
      const int er_ = (et_ >> 5) + 8 * ej_, ec_ = (et_ & 31) * 4;                                  \
      const f32x4 ev_ = *(const f32x4*)((const float*)smem + er_ * 132 + ec_);                     \
      const int pb_ = p0 + ec_, qb_ = q0 + eh_ * 128 + er_;
#define EPI2_END }}
#define TILE_LOOP2(NT) TileIter tit_ = tile_iter_init(); tit_.MTB >>= 1; int mt_, nt_; for (int q_ = tit_.j; tile_of(tit_, q_, (NT), mt_, nt_); q_ += tit_.G)

DI void phase_inproj(const Params& p, char* smem) {
  u16* q_ml = p.B2; u16* k_ml = p.B2 + (size_t)S * 512; u16* kT = p.B6; u16* vT = p.B3; u16* og = p.B4;
  TILE_LOOP(25) {
    f32x4 acc[4][4];
    i32x4_t iacc[4][4];
#pragma unroll
    for (int a = 0; a < 4; ++a)
#pragma unroll
      for (int b = 0; b < 4; ++b) iacc[a][b] = i32x4_t{0, 0, 0, 0};
    const int lane_ = TIDX & 63, wave_ = TIDX >> 6;
    if (nt_ >= 8 && nt_ < 16) {
      const int p0 = mt_ * 128, q0 = nt_ * 128;
      gemm_core_i8(p.Xq8, 1024, p.Win8, 1024, 1024, p0, q0, smem, iacc);
      const int mb_ = p0 + (wave_ >> 1) * 64 + (lane_ >> 4) * 4, nb_ = q0 + (wave_ & 1) * 64 + (lane_ & 15);
#pragma unroll
      for (int a = 0; a < 4; ++a) {
        const float4 sxv = *(const float4*)(p.sxq + mb_ + a * 16);
#pragma unroll
        for (int b = 0; b < 4; ++b) {
          const float swv = p.swin[nb_ + b * 16];
          acc[a][b][0] = (float)iacc[a][b][0] * sxv.x * swv; acc[a][b][1] = (float)iacc[a][b][1] * sxv.y * swv;
          acc[a][b][2] = (float)iacc[a][b][2] * sxv.z * swv; acc[a][b][3] = (float)iacc[a][b][3] * sxv.w * swv;
        }
      }
      EPI_BEGIN
        store4bf(vT + (size_t)(qb_ - 1024) * S + pb_, ev_[0], ev_[1], ev_[2], ev_[3]);
      EPI_END
    } else {
      const int p0 = nt_ * 128, q0 = mt_ * 128;
      gemm_core_i8(p.Win8, 1024, p.Xq8, 1024, 1024, p0, q0, smem, iacc);
      const int nb_ = p0 + (wave_ >> 1) * 64 + (lane_ >> 4) * 4, mb_ = q0 + (wave_ & 1) * 64 + (lane_ & 15);
#pragma unroll
      for (int a = 0; a < 4; ++a) {
        const float4 swv = *(const float4*)(p.swin + nb_ + a * 16);
#pragma unroll
        for (int b = 0; b < 4; ++b) {
          const float sxv = p.sxq[mb_ + b * 16];
          acc[a][b][0] = (float)iacc[a][b][0] * swv.x * sxv; acc[a][b][1] = (float)iacc[a][b][1] * swv.y * sxv;
          acc[a][b][2] = (float)iacc[a][b][2] * swv.z * sxv; acc[a][b][3] = (float)iacc[a][b][3] * swv.w * sxv;
        }
      }
      EPI_BEGIN
        const int n = pb_, m = qb_;
        if (nt_ < 4) {
          store4bf(q_ml + (size_t)m * 512 + n, ev_[0], ev_[1], ev_[2], ev_[3]);
        } else if (nt_ < 8) {
          store4bf(k_ml + (size_t)m * 512 + n - 512, ev_[0], ev_[1], ev_[2], ev_[3]);
        } else if (nt_ < 24) {
          store4bf(og + (size_t)m * 1024 + n - 2048, sigmoidf_(ev_[0]), sigmoidf_(ev_[1]), sigmoidf_(ev_[2]), sigmoidf_(ev_[3]));
        } else {
          const int nn = n - 3072;
          if (nn < 8) {
#pragma unroll
            for (int i = 0; i < 4; ++i) p.igf[m * 8 + nn + i] = ev_[i] + p.a_b_if[nn + i];
          } else if (nn < 16) {
#pragma unroll
            for (int i = 0; i < 4; ++i) p.lf[m * 8 + nn - 8 + i] = logsigmoidf_(ev_[i] + p.a_b_if[nn + i]);
          }
        }
      EPI_END
      if (nt_ >= 4 && nt_ < 8) {
        const int et = TIDX;
        const float* st = (const float*)smem;
#pragma unroll 4
        for (int ej = 0; ej < 16; ++ej) {
          const int nl = (et >> 5) + 8 * ej, ml = (et & 31) * 4;
          store4bf(kT + (size_t)(p0 - 512 + nl) * S + q0 + ml, st[ml * 132 + nl], st[(ml + 1) * 132 + nl], st[(ml + 2) * 132 + nl], st[(ml + 3) * 132 + nl]);
        }
      }
    }
  }
}


DI void phase_ml_local(const Params& p, char* smem) {
  float* sw = (float*)smem;
  const u16* kT = p.B6; const u16* vT = p.B3; float* dC = p.F2;
  const int tid = TIDX, lane = tid & 63, wave = tid >> 6;
  const int r = lane & 31, hh = lane >> 5;
  for (int it = BIDX; it < 2048; it += gridDim.x) {
    const int c = it >> 3, h = it & 7;
    __syncthreads();
    if (wave == 0) {
      const int t = c * 64 + lane;
      const float lfv = p.lf[t * 8 + h], igv = p.igf[t * 8 + h];
      float b = lfv;
#pragma unroll
      for (int o = 1; o < 64; o <<= 1) { float y = __shfl_up(b, o); if (lane >= o) b += y; }
      const float bl = __shfl(b, 63);
      const float ls = bl - b + igv;
      const float mx = wave_max(ls);
      sw[lane] = __expf(ls - mx);
      if (lane == 0) { p.blast[it] = bl; p.mloc[it] = mx; }
    }
    __syncthreads();
    f32x16 acc0, acc1;
#pragma unroll
    for (int i = 0; i < 16; ++i) { acc0[i] = 0.f; acc1[i] = 0.f; }
    const u16* va = vT + (size_t)(h * 128 + wave * 32 + r) * S + c * 64 + hh * 8;
    const u16* kb0 = kT + (size_t)(h * 64 + r) * S + c * 64 + hh * 8;
    const u16* kb1 = kb0 + (size_t)32 * S;
#pragma unroll
    for (int ks = 0; ks < 4; ++ks) {
      const bf16x8 a = *(const bf16x8*)(va + ks * 16);
      const uint4 k0 = *(const uint4*)(kb0 + ks * 16), k1 = *(const uint4*)(kb1 + ks * 16);
      const float* w = sw + ks * 16 + hh * 8;
      const bf16x8 b0 = pack8(bflo(k0.x) * w[0], bfhi(k0.x) * w[1], bflo(k0.y) * w[2], bfhi(k0.y) * w[3],
                              bflo(k0.z) * w[4], bfhi(k0.z) * w[5], bflo(k0.w) * w[6], bfhi(k0.w) * w[7]);
      const bf16x8 b1 = pack8(bflo(k1.x) * w[0], bfhi(k1.x) * w[1], bflo(k1.y) * w[2], bfhi(k1.y) * w[3],
                              bflo(k1.z) * w[4], bfhi(k1.z) * w[5], bflo(k1.w) * w[6], bfhi(k1.w) * w[7]);
      acc0 = mfma32(a, b0, acc0);
      acc1 = mfma32(a, b1, acc1);
    }
    float* dst = dC + (size_t)it * 8192;
#pragma unroll
    for (int i = 0; i < 16; ++i) {
      const int dv = wave * 32 + crow(i, hh);
      dst[dv * 64 + r] = acc0[i];
      dst[dv * 64 + 32 + r] = acc1[i];
    }
    if (tid < 64) {
      const u16* kr = kT + (size_t)(h * 64 + tid) * S + c * 64;
      float s = 0.f;
#pragma unroll
      for (int j = 0; j < 8; ++j) {
        const uint4 kk = *(const uint4*)(kr + j * 8);
        const float* w = sw + j * 8;
        s += bflo(kk.x) * w[0] + bfhi(kk.x) * w[1] + bflo(kk.y) * w[2] + bfhi(kk.y) * w[3] +
             bflo(kk.z) * w[4] + bfhi(kk.z) * w[5] + bflo(kk.w) * w[6] + bfhi(kk.w) * w[7];
      }
      p.dn[it * 64 + tid] = s;
    }
  }
}

DI void phase_ml_scan(const Params& p) {
  const float* __restrict__ dC = p.F2; u16* __restrict__ Cb = p.B1;
  const int total = 8 * 8256, half = total / 2;
  const int nscan = half / 256;
  const int bid = BIDX;
  const bool split = (int)gridDim.x > nscan + 32;
  if (split && bid >= nscan) {
    quant_rows(p.peer_u, p.Uq, p.scU, 2 * 16384, 0, bid - nscan, gridDim.x - nscan);
    quant_rows(p.peer_v, p.Vq, p.scV, 2 * 16384, 0, bid - nscan, gridDim.x - nscan);
    quant_rows_bf16(p.WpqT, p.Wq8, p.swq, 2 * 2048, bid - nscan, gridDim.x - nscan);
    quant_rows_bf16(p.WgT, p.Wg8, p.swg, 2 * 1024, bid - nscan, gridDim.x - nscan);
    return;
  }
  const int nsb = split ? nscan : (int)gridDim.x;
  for (int g = bid * 256 + TIDX; g < half; g += nsb * 256) {
    const int hA = g / 8256, eA = g % 8256, hB = hA + 4, eB = eA;
    const bool isC = eA < 8192;
    float mA = 0.f, CA = 0.f, mB = 0.f, CB = 0.f;
    for (int c0 = 0; c0 < 256; c0 += 8) {
      float dA[8], blA[8], mlA[8], dB[8], blB[8], mlB[8];
#pragma unroll
      for (int j = 0; j < 8; ++j) {
        const int itA = (c0 + j) * 8 + hA, itB = (c0 + j) * 8 + hB;
        dA[j] = isC ? dC[(size_t)itA * 8192 + eA] : p.dn[itA * 64 + eA - 8192];
        dB[j] = isC ? dC[(size_t)itB * 8192 + eB] : p.dn[itB * 64 + eB - 8192];
        blA[j] = p.blast[itA]; mlA[j] = p.mloc[itA];
        blB[j] = p.blast[itB]; mlB[j] = p.mloc[itB];
      }
#pragma unroll
      for (int j = 0; j < 8; ++j) {
        const int itA = (c0 + j) * 8 + hA, itB = (c0 + j) * 8 + hB;
        if (isC) { Cb[(size_t)itA * 8192 + eA] = f2bf(CA); Cb[(size_t)itB * 8192 + eB] = f2bf(CB); }
        else { p.nprev[itA * 64 + eA - 8192] = CA; p.nprev[itB * 64 + eB - 8192] = CB; }
        if (eA == 0) { p.mprev[itA] = mA; p.mprev[itB] = mB; }
        const float mnA = fmaxf(blA[j] + mA, mlA[j]);
        CA = __expf(blA[j] + mA - mnA) * CA + __expf(mlA[j] - mnA) * dA[j];
        mA = mnA;
        const float mnB = fmaxf(blB[j] + mB, mlB[j]);
        CB = __expf(blB[j] + mB - mnB) * CB + __expf(mlB[j] - mnB) * dB[j];
        mB = mnB;
      }
    }
  }
  if (!split) {
    quant_rows(p.peer_u, p.Uq, p.scU, 2 * 16384, 0, bid, gridDim.x);
    quant_rows(p.peer_v, p.Vq, p.scV, 2 * 16384, 0, bid, gridDim.x);
    quant_rows_bf16(p.WpqT, p.Wq8, p.swq, 2 * 2048, bid, gridDim.x);
    quant_rows_bf16(p.WgT, p.Wg8, p.swg, 2 * 1024, bid, gridDim.x);
  }
}

DI void phase_ml_out(const Params& p, char* smem) {
  const u16* q_ml = p.B2; const u16* k_ml = p.B2 + (size_t)S * 512; const u16* vT = p.B3; const u16* og = p.B4;
  const u16* Cb = p.B1; u16* hout = p.B0;
  const int tid = TIDX, lane = tid & 63, wave = tid >> 6;
  float* sA = (float*)smem + wave * 192;
  const int r = lane & 31, hh = lane >> 5;
  for (int bi = BIDX; bi < 1024; bi += gridDim.x) {
    const int it = bi * 2 + (wave >> 1), tt = wave & 1;
    const int c = it >> 3, h = it & 7;
    const float mprev = p.mprev[it];
    {
      const int t = c * 64 + lane;
      const float lfv = p.lf[t * 8 + h], igv = p.igf[t * 8 + h];
      float b = lfv;
#pragma unroll
      for (int o = 1; o < 64; o <<= 1) { float y = __shfl_up(b, o); if (lane >= o) b += y; }
      const float a = igv - b;
      float pm = a;
#pragma unroll
      for (int o = 1; o < 64; o <<= 1) { float y = __shfl_up(pm, o); if (lane >= o) pm = fmaxf(pm, y); }
      const float mt = fmaxf(b + mprev, b + pm);
      __syncthreads();
      sA[lane] = a; sA[64 + lane] = b; sA[128 + lane] = mt;
      __syncthreads();
    }
    const int tl = tt * 32 + r;
    const float b_t = sA[64 + tl], m_t = sA[128 + tl];
    const u16* qp = q_ml + (size_t)(c * 64 + tl) * 512 + h * 64 + hh * 8;
    bf16x8 qf[4];
#pragma unroll
    for (int ks = 0; ks < 4; ++ks) qf[ks] = *(const bf16x8*)(qp + ks * 16);
    f32x16 X[2];
    float den = 0.f;
#pragma unroll
    for (int st = 0; st < 2; ++st) {
#pragma unroll
      for (int i = 0; i < 16; ++i) X[st][i] = 0.f;
      if (st <= tt) {
        const u16* kp = k_ml + (size_t)(c * 64 + st * 32 + r) * 512 + h * 64 + hh * 8;
#pragma unroll
        for (int ks = 0; ks < 4; ++ks) X[st] = mfma32(*(const bf16x8*)(kp + ks * 16), qf[ks], X[st]);
#pragma unroll
        for (int i = 0; i < 16; ++i) {
          const int s = st * 32 + crow(i, hh);
          const float w = (s <= tl) ? __expf(b_t + sA[s] - m_t) : 0.f;
          X[st][i] *= w;
          den += X[st][i];
        }
      }
    }
    f32x16 acc[4];
    const u16* cp = Cb + (size_t)it * 8192 + (size_t)r * 64 + hh * 8;
#pragma unroll
    for (int mt = 0; mt < 4; ++mt) {
#pragma unroll
      for (int i = 0; i < 16; ++i) acc[mt][i] = 0.f;
#pragma unroll
      for (int ks = 0; ks < 4; ++ks) acc[mt] = mfma32(*(const bf16x8*)(cp + mt * 32 * 64 + ks * 16), qf[ks], acc[mt]);
    }
    const float s_inter = __expf(b_t + mprev - m_t);
#pragma unroll
    for (int mt = 0; mt < 4; ++mt)
#pragma unroll
      for (int i = 0; i < 16; ++i) acc[mt][i] *= s_inter;
    {
      float dq = 0.f;
      const float* np = p.nprev + it * 64 + hh * 8;
#pragma unroll
      for (int ks = 0; ks < 4; ++ks)
#pragma unroll
        for (int j = 0; j < 8; ++j) dq += bf2f((u16)qf[ks][j]) * np[ks * 16 + j];
      den += s_inter * dq;
    }
    den += __shfl_xor(den, 32);
#pragma unroll
    for (int st = 0; st < 2; ++st) {
      if (st <= tt) {
#pragma unroll
        for (int k2 = 0; k2 < 2; ++k2) {
          const bf16x8 pf = pack8(X[st][8 * k2 + 0], X[st][8 * k2 + 1], X[st][8 * k2 + 2], X[st][8 * k2 + 3],
                                  X[st][8 * k2 + 4], X[st][8 * k2 + 5], X[st][8 * k2 + 6], X[st][8 * k2 + 7]);
#pragma unroll
          for (int mt = 0; mt < 4; ++mt) {
            const u16* vp = vT + (size_t)(h * 128 + mt * 32 + r) * S + c * 64 + st * 32 + k2 * 16 + hh * 4;
            const s16x4 lo = *(const s16x4*)vp, hi = *(const s16x4*)(vp + 8);
            const bf16x8 a = __builtin_shufflevector(lo, hi, 0, 1, 2, 3, 4, 5, 6, 7);
            acc[mt] = mfma32(a, pf, acc[mt]);
          }
        }
      }
    }
    const float inv = 1.f / fmaxf(fabsf(den), __expf(-m_t));
    float sum = 0.f;
#pragma unroll
    for (int mt = 0; mt < 4; ++mt)
#pragma unroll
      for (int i = 0; i < 16; ++i) { acc[mt][i] *= inv; sum += acc[mt][i]; }
    sum += __shfl_xor(sum, 32);
    const float mean = sum * (1.f / 128.f);
    float vs = 0.f;
#pragma unroll
    for (int mt = 0; mt < 4; ++mt)
#pragma unroll
      for (int i = 0; i < 16; ++i) { const float dd = acc[mt][i] - mean; vs += dd * dd; }
    vs += __shfl_xor(vs, 32);
    const float rstd = rsqrtf(vs * (1.f / 128.f) + NORM_EPS);
    const size_t t = (size_t)c * 64 + tl;
#pragma unroll
    for (int mt = 0; mt < 4; ++mt)
#pragma unroll
      for (int g4 = 0; g4 < 4; ++g4) {
        const int col = h * 128 + mt * 32 + 8 * g4 + 4 * hh;
        const uint2 ogv = *(const uint2*)(og + t * 1024 + col);
        const float4 gv = *(const float4*)(p.a_hn_g + col);
        const float o0 = bflo(ogv.x) * (acc[mt][4 * g4 + 0] - mean) * rstd * gv.x;
        const float o1 = bfhi(ogv.x) * (acc[mt][4 * g4 + 1] - mean) * rstd * gv.y;
        const float o2 = bflo(ogv.y) * (acc[mt][4 * g4 + 2] - mean) * rstd * gv.z;
        const float o3 = bfhi(ogv.y) * (acc[mt][4 * g4 + 3] - mean) * rstd * gv.w;
        store4bf(hout + t * 1024 + col, o0, o1, o2, o3);
      }
  }
}

DI void phase_outproj(const Params& p, int layer, const u16* A, const u16* WT, const float* R, float* Y, char* smem) {
  const u16* WpT = p.WpT + (size_t)layer * 1024 * 256;
  const u16* pbl = p.pb + (size_t)layer * S * 256;
  u16* pe = p.B2;
  TILE_LOOP2(16) {
    f32x4 acc[4][8]; zero_acc2(acc);
    const int p0 = (nt_ & 7) * 128, q0 = mt_ * 256;
    if (nt_ < 8) {
      gemm_core2(WT, 1024, A, 1024, 1024, p0, q0, smem, acc);
      EPI2_BEGIN
        const float4 rv = *(const float4*)(R + (size_t)qb_ * 1024 + pb_);
        float4 o;
        o.x = DN_ALPHA * rv.x + ev_[0]; o.y = DN_ALPHA * rv.y + ev_[1];
        o.z = DN_ALPHA * rv.z + ev_[2]; o.w = DN_ALPHA * rv.w + ev_[3];
        *(float4*)(Y + (size_t)qb_ * 1024 + pb_) = o;
      EPI2_END
    } else {
      gemm_core2(WpT, 256, pbl, 256, 256, p0, q0, smem, acc);
      EPI2_BEGIN
        store4bf(pe + (size_t)qb_ * 1024 + pb_, ev_[0], ev_[1], ev_[2], ev_[3]);
      EPI2_END
    }
  }
}

DI void phase_ln(float* X, u16* Xb, const float* g, const float* bta, u8* Xq, float* sxs) {
  const int lane = TIDX & 63, wave = TIDX >> 6;
  for (int row = BIDX * 4 + wave; row < S; row += gridDim.x * 4) {
    float* xr = X + (size_t)row * 1024;
    float4 v[4];
#pragma unroll
    for (int i = 0; i < 4; ++i) v[i] = *(const float4*)(xr + i * 256 + lane * 4);
    float s = 0.f;
#pragma unroll
    for (int i = 0; i < 4; ++i) s += v[i].x + v[i].y + v[i].z + v[i].w;
    const float mean = wave_sum(s) * (1.f / 1024.f);
    float q = 0.f;
#pragma unroll
    for (int i = 0; i < 4; ++i) {
      v[i].x -= mean; v[i].y -= mean; v[i].z -= mean; v[i].w -= mean;
      q += v[i].x * v[i].x + v[i].y * v[i].y + v[i].z * v[i].z + v[i].w * v[i].w;
    }
    const float rstd = rsqrtf(wave_sum(q) * (1.f / 1024.f) + NORM_EPS);
    float amax = 0.f;
#pragma unroll
    for (int i = 0; i < 4; ++i) {
      const float4 gv = *(const float4*)(g + i * 256 + lane * 4), bv = *(const float4*)(bta + i * 256 + lane * 4);
      float4 o;
      o.x = v[i].x * rstd * gv.x + bv.x; o.y = v[i].y * rstd * gv.y + bv.y;
      o.z = v[i].z * rstd * gv.z + bv.z; o.w = v[i].w * rstd * gv.w + bv.w;
      *(float4*)(xr + i * 256 + lane * 4) = o;
      v[i] = o;
      amax = fmaxf(amax, absmax4(o));
    }
    amax = wave_max(amax);
    const float sc = amax > 0.f ? amax * (1.f / 127.f) : 1.f;
    const float inv = 1.f / sc;
#pragma unroll
    for (int i = 0; i < 4; ++i) *(unsigned*)(Xq + (size_t)row * 1024 + i * 256 + lane * 4) = q8x4(v[i], inv, 0);
    if (lane == 0) sxs[row] = sc;
  }
}

DI void phase_peer_query(const Params& p, int layer, const u16* Xb, char* smem) {
  const u16* WT = p.WpqT + (size_t)layer * 2048 * 1024;
  const u16* SK = p.SubK + (size_t)layer * 16 * 128 * 128;
  float* topk = (float*)p.B6;
  const int tid = TIDX, lane = tid & 63, wave = tid >> 6;
  TILE_LOOP(16) {
    const int slot = nt_;
    f32x4 acc[4][4];
    {
      const int p0 = slot * 128, q0 = mt_ * 128;
      i32x4_t iacc[4][4];
#pragma unroll
      for (int a = 0; a < 4; ++a)
#pragma unroll
        for (int b = 0; b < 4; ++b) iacc[a][b] = i32x4_t{0, 0, 0, 0};
      gemm_core_i8(p.Wq8 + (size_t)layer * 2048 * 1024, 1024, p.Xq8, 1024, 1024, p0, q0, smem, iacc);
      const int nb_ = p0 + (wave >> 1) * 64 + (lane >> 4) * 4, mb_ = q0 + (wave & 1) * 64 + (lane & 15);
      const float* swl = p.swq + layer * 2048;
#pragma unroll
      for (int a = 0; a < 4; ++a) {
        const float4 swv = *(const float4*)(swl + nb_ + a * 16);
#pragma unroll
        for (int b = 0; b < 4; ++b) {
          const float sxv = p.sxq[mb_ + b * 16];
          acc[a][b][0] = (float)iacc[a][b][0] * swv.x * sxv; acc[a][b][1] = (float)iacc[a][b][1] * swv.y * sxv;
          acc[a][b][2] = (float)iacc[a][b][2] * swv.z * sxv; acc[a][b][3] = (float)iacc[a][b][3] * swv.w * sxv;
        }
      }
    }
    u16* sq = (u16*)smem; u16* sk = (u16*)(smem + 128 * 136 * 2);
    {
      const int pl = (wave >> 1) * 64 + (lane >> 4) * 4, ql = (wave & 1) * 64 + (lane & 15);
#pragma unroll
      for (int a = 0; a < 4; ++a)
#pragma unroll
        for (int b = 0; b < 4; ++b)
          store4bf(sq + (ql + b * 16) * 136 + pl + a * 16, acc[a][b][0], acc[a][b][1], acc[a][b][2], acc[a][b][3]);
      const u16* skg = SK + (size_t)slot * 128 * 128;
#pragma unroll
      for (int i = 0; i < 8; ++i) {
        const int ch = tid + 256 * i, row = ch >> 4, cc = (ch & 15) * 8;
        *(uint4*)(sk + row * 136 + cc) = *(const uint4*)(skg + row * 128 + cc);
      }
    }
    __syncthreads();
    zero_acc(acc);
    {
      const int wp = wave >> 1, wq = wave & 1;
#pragma unroll
      for (int ks = 0; ks < 4; ++ks) {
        bf16x8 fa[4], fb[4];
#pragma unroll
        for (int mt = 0; mt < 4; ++mt) fa[mt] = *(const bf16x8*)(sk + (wp * 64 + mt * 16 + (lane & 15)) * 136 + ks * 32 + (lane >> 4) * 8);
#pragma unroll
        for (int nt = 0; nt < 4; ++nt) fb[nt] = *(const bf16x8*)(sq + (wq * 64 + nt * 16 + (lane & 15)) * 136 + ks * 32 + (lane >> 4) * 8);
#pragma unroll
        for (int mt = 0; mt < 4; ++mt)
#pragma unroll
          for (int nt = 0; nt < 4; ++nt) acc[mt][nt] = mfma16(fa[mt], fb[nt], acc[mt][nt]);
      }
    }
    __syncthreads();
    float* sc = (float*)smem;
    {
      const int kl = (wave >> 1) * 64 + (lane >> 4) * 4, tl = (wave & 1) * 64 + (lane & 15);
#pragma unroll
      for (int a = 0; a < 4; ++a)
#pragma unroll
        for (int b = 0; b < 4; ++b)
#pragma unroll
          for (int i = 0; i < 4; ++i) sc[(tl + b * 16) * 129 + kl + a * 16 + i] = acc[a][b][i];
    }
    __syncthreads();
    const int row = tid & 127, half = tid >> 7;
    float v[16];
#pragma unroll
    for (int i = 0; i < 16; ++i) v[i] = -INFINITY;
#pragma unroll 4
    for (int j = 0; j < 64; ++j) {
      const int key = half * 64 + j;
      const float s = sc[row * 129 + key];
      float x = __uint_as_float((__float_as_uint(s) & ~127u) | (unsigned)(127 - key));
#pragma unroll
      for (int i = 0; i < 16; ++i) { const float hi = fmaxf(v[i], x); x = fminf(v[i], x); v[i] = hi; }
    }
    __syncthreads();
    if (half) {
#pragma unroll
      for (int i = 0; i < 16; ++i) sc[row * 17 + i] = v[i];
    }
    __syncthreads();
    if (!half) {
#pragma unroll
      for (int j = 0; j < 16; ++j) {
        float x = sc[row * 17 + j];
#pragma unroll
        for (int i = 0; i < 16; ++i) { const float hi = fmaxf(v[i], x); x = fminf(v[i], x); v[i] = hi; }
      }
      float* dst = topk + ((size_t)(mt_ * 128 + row) * 16 + slot) * 16;
#pragma unroll
      for (int i = 0; i < 4; ++i) *(float4*)(dst + i * 4) = make_float4(v[4 * i], v[4 * i + 1], v[4 * i + 2], v[4 * i + 3]);
    }
  }
}

__device__ const unsigned char kCandI[64] = {
  0,0,0,0,0,0,0,0,0,0,0,0,0,0,0,0, 1,1,1,1,1,1,1,1, 2,2,2,2,2, 3,3,3,3, 4,4,4, 5,5, 6,6, 7,7, 8,9,10,11,12,13,14,15,
  0,0,0,0,0,0,0,0,0,0,0,0,0,0};
__device__ const unsigned char kCandJ[64] = {
  0,1,2,3,4,5,6,7,8,9,10,11,12,13,14,15, 0,1,2,3,4,5,6,7, 0,1,2,3,4, 0,1,2,3, 0,1,2, 0,1, 0,1, 0,1, 0,0,0,0,0,0,0,0,
  0,0,0,0,0,0,0,0,0,0,0,0,0,0};

DI void phase_peer_gather(const Params& p, int layer, const float* Xin, float* Xout, u16* Xoutb, const float* lng,
                          const float* lnb, char* smem) {
  const int tid = TIDX, lane = tid & 63, wave = tid >> 6;
  char* wsm = smem + wave * 3072;
  float* stk = (float*)wsm; int* sidx = (int*)(wsm + 1024); float* swt = (float*)(wsm + 1536); float* sact = (float*)(wsm + 2048);
  const u8* U = p.Uq + (size_t)layer * 16384 * 1024;
  const u8* V = p.Vq + (size_t)layer * 16384 * 1024;
  const float* scU = p.scU + layer * 16384;
  const float* scV = p.scV + layer * 16384;
  const float* topk = (const float*)p.B6;
  const int ci = kCandI[lane], cj = kCandJ[lane];
  float4 nx0, nx1, nx2, nx3, ntk;
  {
    const int tok0 = BIDX * 4 + wave;
    const float* xr = Xin + (size_t)tok0 * 1024 + lane * 16;
    nx0 = *(const float4*)xr; nx1 = *(const float4*)(xr + 4); nx2 = *(const float4*)(xr + 8); nx3 = *(const float4*)(xr + 12);
    ntk = *(const float4*)(topk + (size_t)tok0 * 256 + lane * 4);
  }
  for (int bi = BIDX; bi < S / 4; bi += gridDim.x) {
    const int tok = bi * 4 + wave;
    const float4 x0 = nx0, x1 = nx1, x2 = nx2, x3 = nx3, tkv = ntk;
    {
      const int bn = (bi + (int)gridDim.x < S / 4) ? bi + (int)gridDim.x : bi;
      const int tokn = bn * 4 + wave;
      const float* xr = Xin + (size_t)tokn * 1024 + lane * 16;
      nx0 = *(const float4*)xr; nx1 = *(const float4*)(xr + 4); nx2 = *(const float4*)(xr + 8); nx3 = *(const float4*)(xr + 12);
      ntk = *(const float4*)(topk + (size_t)tokn * 256 + lane * 4);
    }
    float mxa = fmaxf(fmaxf(absmax4(x0), absmax4(x1)), fmaxf(absmax4(x2), absmax4(x3)));
    mxa = wave_max(mxa);
    const float sx = mxa > 0.f ? mxa * (1.f / 127.f) : 1.f;
    const float sxi = 1.f / sx;
    __builtin_amdgcn_fence(__ATOMIC_ACQ_REL, "wavefront");
    *(float4*)(stk + lane * 4) = tkv;
#pragma unroll 1
    for (int h = 0; h < 8; ++h) {
      const unsigned ua = __float_as_uint(stk[(h * 2) * 16 + ci]);
      const unsigned ub = __float_as_uint(stk[(h * 2 + 1) * 16 + cj]);
      const float val = (lane < 50) ? __uint_as_float(ua & ~127u) + __uint_as_float(ub & ~127u) : -3.0e38f;
      const int eidx = (127 - (int)(ua & 127u)) * 128 + (127 - (int)(ub & 127u));
      const float key = __uint_as_float((__float_as_uint(val) & ~63u) | (unsigned)(63 - lane));
      const int kbits = (int)__float_as_uint(key);
      int cnt = 0;
#pragma unroll 10
      for (int j = 0; j < 50; ++j) {
        const float vj = __uint_as_float((unsigned)__builtin_amdgcn_readlane(kbits, j));
        cnt += (vj > key) ? 1 : 0;
      }
      const float mx = __uint_as_float((unsigned)__builtin_amdgcn_readlane((int)__float_as_uint(val), 0));
      const float e = (cnt < 16) ? __expf(val - mx) : 0.f;
      const float sum = wave_sum(e);
      if (cnt < 16) { sidx[h * 16 + cnt] = eidx; swt[h * 16 + cnt] = e / sum; }
    }
    __builtin_amdgcn_fence(__ATOMIC_ACQ_REL, "wavefront");
    {
      const int xq0 = (int)q8x4(x0, sxi, 0), xq1 = (int)q8x4(x1, sxi, 0), xq2 = (int)q8x4(x2, sxi, 0), xq3 = (int)q8x4(x3, sxi, 0);
      const bool b5 = (lane & 32) != 0, b4 = (lane & 16) != 0, b3 = (lane & 8) != 0;
      const int eslot = (b5 ? 4 : 0) + (b4 ? 2 : 0) + (b3 ? 1 : 0);
#pragma unroll 2
      for (int e0 = 0; e0 < 128; e0 += 8) {
        i32x4 a[8];
#pragma unroll
        for (int j2 = 0; j2 < 8; ++j2) {
          const int ei = __builtin_amdgcn_readfirstlane(sidx[e0 + j2]);
          a[j2] = *(const i32x4*)(U + (size_t)ei * 1024 + lane * 16);
        }
        int pp[8];
#pragma unroll
        for (int j2 = 0; j2 < 8; ++j2) {
          int c = __builtin_amdgcn_sdot4(a[j2][0], xq0, 0, false);
          c = __builtin_amdgcn_sdot4(a[j2][1], xq1, c, false);
          c = __builtin_amdgcn_sdot4(a[j2][2], xq2, c, false);
          pp[j2] = __builtin_amdgcn_sdot4(a[j2][3], xq3, c, false);
        }
        int qq[4];
#pragma unroll
        for (int j2 = 0; j2 < 4; ++j2) {
          const int snd = b5 ? pp[j2] : pp[j2 + 4];
          const int keep = b5 ? pp[j2 + 4] : pp[j2];
          qq[j2] = keep + __shfl_xor(snd, 32);
        }
        int rr[2];
#pragma unroll
        for (int j2 = 0; j2 < 2; ++j2) {
          const int snd = b4 ? qq[j2] : qq[j2 + 2];
          const int keep = b4 ? qq[j2 + 2] : qq[j2];
          rr[j2] = keep + __shfl_xor(snd, 16);
        }
        int ss;
        {
          const int snd = b3 ? rr[0] : rr[1];
          const int keep = b3 ? rr[1] : rr[0];
          ss = keep + __shfl_xor(snd, 8);
        }
        ss += __shfl_xor(ss, 4);
        ss += __shfl_xor(ss, 2);
        ss += __shfl_xor(ss, 1);
        if ((lane & 7) == 0) sact[e0 + eslot] = (float)ss;
      }
    }
    __builtin_amdgcn_fence(__ATOMIC_ACQ_REL, "wavefront");
    float scw;
    {
      float wv[2];
#pragma unroll
      for (int q2 = 0; q2 < 2; ++q2) {
        const int e = lane + 64 * q2;
        const int idx = sidx[e];
        const float a = sact[e] * sx * scU[idx];
        wv[q2] = swt[e] * 0.5f * a * (1.f + erff(a * 0.70710678118654752f)) * scV[idx];
      }
      const float wm = wave_max(fmaxf(fabsf(wv[0]), fabsf(wv[1])));
      scw = wm > 0.f ? wm * (1.f / 127.f) : 1.f;
      const float winv = 1.f / scw;
      u8* sw8 = (u8*)swt;
      __builtin_amdgcn_fence(__ATOMIC_ACQ_REL, "wavefront");
      sw8[lane] = (u8)q8(wv[0], winv, 0);
      sw8[lane + 64] = (u8)q8(wv[1], winv, 0);
    }
    __builtin_amdgcn_fence(__ATOMIC_ACQ_REL, "wavefront");
    int oi[16];
#pragma unroll
    for (int i = 0; i < 16; ++i) oi[i] = 0;
    const unsigned* sw32 = (const unsigned*)swt;
#pragma unroll 1
    for (int e0 = 0; e0 < 128; e0 += 8) {
      u32x4 bb[8];
#pragma unroll
      for (int j = 0; j < 8; ++j) {
        const int ei = __builtin_amdgcn_readfirstlane(sidx[e0 + j]);
        bb[j] = *(const u32x4*)(V + (size_t)ei * 1024 + lane * 16);
      }
#pragma unroll
      for (int g = 0; g < 2; ++g) {
        const int w4 = (int)sw32[(e0 >> 2) + g];
#pragma unroll
        for (int d = 0; d < 4; ++d) {
          const unsigned r0 = bb[4 * g][d], r1 = bb[4 * g + 1][d], r2 = bb[4 * g + 2][d], r3 = bb[4 * g + 3][d];
          const unsigned ta = __builtin_amdgcn_perm(r1, r0, 0x05010400u);
          const unsigned tb = __builtin_amdgcn_perm(r3, r2, 0x05010400u);
          const unsigned tc = __builtin_amdgcn_perm(r1, r0, 0x07030602u);
          const unsigned td = __builtin_amdgcn_perm(r3, r2, 0x07030602u);
          const unsigned c0 = __builtin_amdgcn_perm(tb, ta, 0x05040100u);
          const unsigned c1 = __builtin_amdgcn_perm(tb, ta, 0x07060302u);
          const unsigned c2 = __builtin_amdgcn_perm(td, tc, 0x05040100u);
          const unsigned c3 = __builtin_amdgcn_perm(td, tc, 0x07060302u);
          oi[4 * d + 0] = __builtin_amdgcn_sdot4((int)c0, w4, oi[4 * d + 0], false);
          oi[4 * d + 1] = __builtin_amdgcn_sdot4((int)c1, w4, oi[4 * d + 1], false);
          oi[4 * d + 2] = __builtin_amdgcn_sdot4((int)c2, w4, oi[4 * d + 2], false);
          oi[4 * d + 3] = __builtin_amdgcn_sdot4((int)c3, w4, oi[4 * d + 3], false);
        }
      }
    }
    const float corr = 0.f;
    float o[16];
#pragma unroll
    for (int i = 0; i < 16; ++i) o[i] = (float)oi[i] * scw;
    float y[16];
    y[0] = DN_ALPHA * x0.x + o[0] - corr; y[1] = DN_ALPHA * x0.y + o[1] - corr; y[2] = DN_ALPHA * x0.z + o[2] - corr; y[3] = DN_ALPHA * x0.w + o[3] - corr;
    y[4] = DN_ALPHA * x1.x + o[4] - corr; y[5] = DN_ALPHA * x1.y + o[5] - corr; y[6] = DN_ALPHA * x1.z + o[6] - corr; y[7] = DN_ALPHA * x1.w + o[7] - corr;
    y[8] = DN_ALPHA * x2.x + o[8] - corr; y[9] = DN_ALPHA * x2.y + o[9] - corr; y[10] = DN_ALPHA * x2.z + o[10] - corr; y[11] = DN_ALPHA * x2.w + o[11] - corr;
    y[12] = DN_ALPHA * x3.x + o[12] - corr; y[13] = DN_ALPHA * x3.y + o[13] - corr; y[14] = DN_ALPHA * x3.z + o[14] - corr; y[15] = DN_ALPHA * x3.w + o[15] - corr;
    float s_ = 0.f;
#pragma unroll
    for (int i = 0; i < 16; ++i) s_ += y[i];
    const float mean = wave_sum(s_) * (1.f / 1024.f);
    float q = 0.f;
#pragma unroll
    for (int i = 0; i < 16; ++i) { y[i] -= mean; q += y[i] * y[i]; }
    const float rstd = rsqrtf(wave_sum(q) * (1.f / 1024.f) + NORM_EPS);
    const int col = lane * 16;
    float r_[16];
#pragma unroll
    for (int i = 0; i < 16; ++i) r_[i] = y[i] * rstd * lng[col + i] + lnb[col + i];
    float* xo = Xout + (size_t)tok * 1024 + col;
#pragma unroll
    for (int i = 0; i < 4; ++i) *(float4*)(xo + 4 * i) = make_float4(r_[4 * i], r_[4 * i + 1], r_[4 * i + 2], r_[4 * i + 3]);
    {
      float am = 0.f;
#pragma unroll
      for (int i = 0; i < 16; ++i) am = fmaxf(am, fabsf(r_[i]));
      am = wave_max(am);
      const float sc = am > 0.f ? am * (1.f / 127.f) : 1.f;
      const float inv = 1.f / sc;
      u32x4 o8;
#pragma unroll
      for (int k = 0; k < 4; ++k) o8[k] = q8(r_[4 * k], inv, 0) | (q8(r_[4 * k + 1], inv, 0) << 8) | (q8(r_[4 * k + 2], inv, 0) << 16) | (q8(r_[4 * k + 3], inv, 0) << 24);
      *(u32x4*)(p.Xq8 + (size_t)tok * 1024 + col) = o8;
      if (lane == 0) p.sxq[tok] = sc;
    }
  }
}

DI void phase_peer_u(const Params& p, int layer, const float* Xin, char* smem) {
  const int tid = TIDX, lane = tid & 63, wave = tid >> 6;
  char* wsm = smem + wave * 13312;
  u8* sxq = (u8*)wsm;
  int* sidx = (int*)(wsm + 4096);
  float* sgate = (float*)(wsm + 6144);
  float* sact = (float*)(wsm + 8192);
  unsigned* slist = (unsigned*)(wsm + 10240);
  float* stk = (float*)(wsm + 12288);
  const u8* U = p.Uq + (size_t)layer * 16384 * 1024;
  const float* scU = p.scU + layer * 16384;
  const float* scV = p.scV + layer * 16384;
  float* topk = (float*)p.B6;
  const int ci = kCandI[lane], cj = kCandJ[lane];
  const int ntw = (S / 4) / (int)gridDim.x;
  for (int g0 = 0; g0 < ntw; g0 += 4) {
    float sxr[4];
    unsigned ent[8];
#pragma unroll
    for (int k = 0; k < 4; ++k) {
      const int tok = (BIDX + (g0 + k) * (int)gridDim.x) * 4 + wave;
      const float* xr = Xin + (size_t)tok * 1024 + lane * 16;
      const float4 x0 = *(const float4*)xr, x1 = *(const float4*)(xr + 4), x2 = *(const float4*)(xr + 8), x3 = *(const float4*)(xr + 12);
      const float4 tkv = *(const float4*)(topk + (size_t)tok * 256 + lane * 4);
      float mxa = fmaxf(fmaxf(absmax4(x0), absmax4(x1)), fmaxf(absmax4(x2), absmax4(x3)));
      mxa = wave_max(mxa);
      const float sx = mxa > 0.f ? mxa * (1.f / 127.f) : 1.f;
      const float sxi = 1.f / sx;
      sxr[k] = sx;
      {
        u32x4 o; o[0] = q8x4(x0, sxi, 0); o[1] = q8x4(x1, sxi, 0); o[2] = q8x4(x2, sxi, 0); o[3] = q8x4(x3, sxi, 0);
        *(u32x4*)(sxq + k * 1024 + lane * 16) = o;
      }
      __builtin_amdgcn_fence(__ATOMIC_ACQ_REL, "wavefront");
      *(float4*)(stk + lane * 4) = tkv;
      __builtin_amdgcn_fence(__ATOMIC_ACQ_REL, "wavefront");
#pragma unroll 1
      for (int h = 0; h < 8; ++h) {
        const unsigned ua = __float_as_uint(stk[(h * 2) * 16 + ci]);
        const unsigned ub = __float_as_uint(stk[(h * 2 + 1) * 16 + cj]);
        const float val = (lane < 50) ? __uint_as_float(ua & ~127u) + __uint_as_float(ub & ~127u) : -3.0e38f;
        const int eidx = (127 - (int)(ua & 127u)) * 128 + (127 - (int)(ub & 127u));
        const float key = __uint_as_float((__float_as_uint(val) & ~63u) | (unsigned)(63 - lane));
        const int kbits = (int)__float_as_uint(key);
        int cnt = 0;
#pragma unroll 10
        for (int j = 0; j < 50; ++j) {
          const float vj = __uint_as_float((unsigned)__builtin_amdgcn_readlane(kbits, j));
          cnt += (vj > key) ? 1 : 0;
        }
        const float mx = __uint_as_float((unsigned)__builtin_amdgcn_readlane((int)__float_as_uint(val), 0));
        const float e = (cnt < 16) ? __expf(val - mx) : 0.f;
        const float sum = wave_sum(e);
        if (cnt < 16) { sidx[k * 128 + h * 16 + cnt] = eidx; sgate[k * 128 + h * 16 + cnt] = e / sum; }
      }
      __builtin_amdgcn_fence(__ATOMIC_ACQ_REL, "wavefront");
      ent[2 * k] = (unsigned)sidx[k * 128 + lane] | ((unsigned)k << 14) | ((unsigned)lane << 17);
      ent[2 * k + 1] = (unsigned)sidx[k * 128 + lane + 64] | ((unsigned)k << 14) | ((unsigned)(lane + 64) << 17);
    }
    {
      int base = 0;
#pragma unroll 1
      for (int r = 0; r < 8; ++r) {
#pragma unroll
        for (int q2 = 0; q2 < 8; ++q2) {
          const bool mine = (int)((ent[q2] & 0x3fffu) >> 11) == r;
          const unsigned long long m = __builtin_amdgcn_ballot_w64(mine);
          if (mine) slist[base + (int)__builtin_amdgcn_mbcnt_hi((unsigned)(m >> 32), __builtin_amdgcn_mbcnt_lo((unsigned)m, 0u))] = ent[q2];
          base += __builtin_popcountll(m);
        }
      }
    }
    __builtin_amdgcn_fence(__ATOMIC_ACQ_REL, "wavefront");
    {
      const bool b5 = (lane & 32) != 0, b4 = (lane & 16) != 0, b3 = (lane & 8) != 0;
      const int eslot = (b5 ? 4 : 0) + (b4 ? 2 : 0) + (b3 ? 1 : 0);
      unsigned evn = slist[lane & 7];
#pragma unroll 2
      for (int c = 0; c < 64; ++c) {
        i32x4 a[8], xq[8];
        int adr[8];
        const int ev = (int)evn;
        evn = slist[((c + 1 < 64) ? c + 1 : c) * 8 + (lane & 7)];
#pragma unroll
        for (int j2 = 0; j2 < 8; ++j2) {
          const unsigned en = (unsigned)__builtin_amdgcn_readlane(ev, j2);
          const int ei = (int)(en & 0x3fffu), kk = (int)((en >> 14) & 7u);
          adr[j2] = kk * 128 + (int)(en >> 17);
          a[j2] = *(const i32x4*)(U + (size_t)ei * 1024 + lane * 16);
          xq[j2] = *(const i32x4*)(sxq + kk * 1024 + lane * 16);
        }
        int pp[8];
#pragma unroll
        for (int j2 = 0; j2 < 8; ++j2) {
          int cc = __builtin_amdgcn_sdot4(a[j2][0], xq[j2][0], 0, false);
          cc = __builtin_amdgcn_sdot4(a[j2][1], xq[j2][1], cc, false);
          cc = __builtin_amdgcn_sdot4(a[j2][2], xq[j2][2], cc, false);
          pp[j2] = __builtin_amdgcn_sdot4(a[j2][3], xq[j2][3], cc, false);
        }
        int qq[4];
#pragma unroll
        for (int j2 = 0; j2 < 4; ++j2) {
          const auto sw = __builtin_amdgcn_permlane32_swap((unsigned)pp[j2], (unsigned)pp[j2 + 4], false, false);
          qq[j2] = (int)sw[0] + (int)sw[1];
        }
        int rr[2];
#pragma unroll
        for (int j2 = 0; j2 < 2; ++j2) {
          const auto sw = __builtin_amdgcn_permlane16_swap((unsigned)qq[j2], (unsigned)qq[j2 + 2], false, false);
          rr[j2] = (int)sw[0] + (int)sw[1];
        }
        int ss;
        {
          const int snd = b3 ? rr[0] : rr[1];
          const int keep = b3 ? rr[1] : rr[0];
          ss = keep + __builtin_amdgcn_update_dpp(0, snd, 0x140, 0xf, 0xf, true);
        }
        ss += __builtin_amdgcn_update_dpp(0, ss, 0xB1, 0xf, 0xf, true);
        ss += __builtin_amdgcn_update_dpp(0, ss, 0x4E, 0xf, 0xf, true);
        ss += __builtin_amdgcn_update_dpp(0, ss, 0x141, 0xf, 0xf, true);
        int ad = adr[0];
#pragma unroll
        for (int j2 = 1; j2 < 8; ++j2) ad = (eslot == j2) ? adr[j2] : ad;
        if ((lane & 7) == 0) sact[ad] = (float)ss;
      }
    }
    __builtin_amdgcn_fence(__ATOMIC_ACQ_REL, "wavefront");
#pragma unroll
    for (int k = 0; k < 4; ++k) {
      const int tok = (BIDX + (g0 + k) * (int)gridDim.x) * 4 + wave;
      int* gl = (int*)(topk + (size_t)tok * 256);
#pragma unroll
      for (int q2 = 0; q2 < 2; ++q2) {
        const int e = lane + 64 * q2;
        const int idx = sidx[k * 128 + e];
        const float a = sact[k * 128 + e] * sxr[k] * scU[idx];
        gl[e] = idx;
        ((float*)gl)[128 + e] = sgate[k * 128 + e] * 0.5f * a * (1.f + erff(a * 0.70710678118654752f)) * scV[idx];
      }
    }
    __builtin_amdgcn_fence(__ATOMIC_ACQ_REL, "wavefront");
  }
}

DI void phase_peer_v(const Params& p, int layer, const float* Xin, float* Xout, const float* lng, const float* lnb, char* smem) {
  const int tid = TIDX, lane = tid & 63, wave = tid >> 6;
  char* wsm = smem + wave * 2048;
  int* sidx = (int*)wsm; float* swt = (float*)(wsm + 512); int* sraw = (int*)(wsm + 1024);
  const u8* V = p.Vq + (size_t)layer * 16384 * 1024;
  const float* lists = (const float*)p.B6;
  float4 nx0, nx1, nx2, nx3, nlv;
  {
    const int tok0 = BIDX * 4 + wave;
    const float* xr = Xin + (size_t)tok0 * 1024 + lane * 16;
    nx0 = *(const float4*)xr; nx1 = *(const float4*)(xr + 4); nx2 = *(const float4*)(xr + 8); nx3 = *(const float4*)(xr + 12);
    nlv = *(const float4*)(lists + (size_t)tok0 * 256 + lane * 4);
  }
  for (int bi = BIDX; bi < S / 4; bi += gridDim.x) {
    const int tok = bi * 4 + wave;
    const float4 x0 = nx0, x1 = nx1, x2 = nx2, x3 = nx3, lv = nlv;
    {
      const int bn = (bi + (int)gridDim.x < S / 4) ? bi + (int)gridDim.x : bi;
      const int tokn = bn * 4 + wave;
      const float* xr = Xin + (size_t)tokn * 1024 + lane * 16;
      nx0 = *(const float4*)xr; nx1 = *(const float4*)(xr + 4); nx2 = *(const float4*)(xr + 8); nx3 = *(const float4*)(xr + 12);
      nlv = *(const float4*)(lists + (size_t)tokn * 256 + lane * 4);
    }
    __builtin_amdgcn_fence(__ATOMIC_ACQ_REL, "wavefront");
    *(float4*)((float*)sraw + lane * 4) = lv;
    __builtin_amdgcn_fence(__ATOMIC_ACQ_REL, "wavefront");
    float scw;
    {
      const int i0 = sraw[lane], i1 = sraw[lane + 64];
      const float w0 = __int_as_float(sraw[128 + lane]), w1 = __int_as_float(sraw[128 + lane + 64]);
      const float wm = wave_max(fmaxf(fabsf(w0), fabsf(w1)));
      scw = wm > 0.f ? wm * (1.f / 127.f) : 1.f;
      const float winv = 1.f / scw;
      const unsigned q0 = q8(w0, winv, 0), q1 = q8(w1, winv, 0);
      u8* sw8 = (u8*)swt;
      const int r0 = i0 >> 11, r1 = i1 >> 11;
      int base = 0;
#pragma unroll 1
      for (int r = 0; r < 8; ++r) {
        const unsigned long long m0 = __builtin_amdgcn_ballot_w64(r0 == r);
        const unsigned long long m1 = __builtin_amdgcn_ballot_w64(r1 == r);
        const int c0 = __builtin_popcountll(m0);
        if (r0 == r) {
          const int pos = base + (int)__builtin_amdgcn_mbcnt_hi((unsigned)(m0 >> 32), __builtin_amdgcn_mbcnt_lo((unsigned)m0, 0u));
          sidx[pos] = i0; sw8[pos] = (u8)q0;
        }
        if (r1 == r) {
          const int pos = base + c0 + (int)__builtin_amdgcn_mbcnt_hi((unsigned)(m1 >> 32), __builtin_amdgcn_mbcnt_lo((unsigned)m1, 0u));
          sidx[pos] = i1; sw8[pos] = (u8)q1;
        }
        base += c0 + __builtin_popcountll(m1);
      }
    }
    __builtin_amdgcn_fence(__ATOMIC_ACQ_REL, "wavefront");
    int oi[16];
#pragma unroll
    for (int i = 0; i < 16; ++i) oi[i] = 0;
    const unsigned* sw32 = (const unsigned*)swt;
    int ivn = sidx[lane & 7];
#pragma unroll 1
    for (int e0 = 0; e0 < 128; e0 += 8) {
      u32x4 bb[8];
      const int iv = ivn;
      ivn = sidx[((e0 + 8 < 128) ? e0 + 8 : e0) + (lane & 7)];
#pragma unroll
      for (int j = 0; j < 8; ++j) {
        const int ei = __builtin_amdgcn_readlane(iv, j);
        bb[j] = *(const u32x4*)(V + (size_t)ei * 1024 + lane * 16);
      }
#pragma unroll
      for (int g = 0; g < 2; ++g) {
        const int w4 = (int)sw32[(e0 >> 2) + g];
#pragma unroll
        for (int d = 0; d < 4; ++d) {
          const unsigned r0 = bb[4 * g][d], r1 = bb[4 * g + 1][d], r2 = bb[4 * g + 2][d], r3 = bb[4 * g + 3][d];
          const unsigned ta = __builtin_amdgcn_perm(r1, r0, 0x05010400u);
          const unsigned tb = __builtin_amdgcn_perm(r3, r2, 0x05010400u);
          const unsigned tc = __builtin_amdgcn_perm(r1, r0, 0x07030602u);
          const unsigned td = __builtin_amdgcn_perm(r3, r2, 0x07030602u);
          const unsigned c0 = __builtin_amdgcn_perm(tb, ta, 0x05040100u);
          const unsigned c1 = __builtin_amdgcn_perm(tb, ta, 0x07060302u);
          const unsigned c2 = __builtin_amdgcn_perm(td, tc, 0x05040100u);
          const unsigned c3 = __builtin_amdgcn_perm(td, tc, 0x07060302u);
          oi[4 * d + 0] = __builtin_amdgcn_sdot4((int)c0, w4, oi[4 * d + 0], false);
          oi[4 * d + 1] = __builtin_amdgcn_sdot4((int)c1, w4, oi[4 * d + 1], false);
          oi[4 * d + 2] = __builtin_amdgcn_sdot4((int)c2, w4, oi[4 * d + 2], false);
          oi[4 * d + 3] = __builtin_amdgcn_sdot4((int)c3, w4, oi[4 * d + 3], false);
        }
      }
    }
    const float corr = 0.f;
    float o[16];
#pragma unroll
    for (int i = 0; i < 16; ++i) o[i] = (float)oi[i] * scw;
    float y[16];
    y[0] = DN_ALPHA * x0.x + o[0] - corr; y[1] = DN_ALPHA * x0.y + o[1] - corr; y[2] = DN_ALPHA * x0.z + o[2] - corr; y[3] = DN_ALPHA * x0.w + o[3] - corr;
    y[4] = DN_ALPHA * x1.x + o[4] - corr; y[5] = DN_ALPHA * x1.y + o[5] - corr; y[6] = DN_ALPHA * x1.z + o[6] - corr; y[7] = DN_ALPHA * x1.w + o[7] - corr;
    y[8] = DN_ALPHA * x2.x + o[8] - corr; y[9] = DN_ALPHA * x2.y + o[9] - corr; y[10] = DN_ALPHA * x2.z + o[10] - corr; y[11] = DN_ALPHA * x2.w + o[11] - corr;
    y[12] = DN_ALPHA * x3.x + o[12] - corr; y[13] = DN_ALPHA * x3.y + o[13] - corr; y[14] = DN_ALPHA * x3.z + o[14] - corr; y[15] = DN_ALPHA * x3.w + o[15] - corr;
    float s_ = 0.f;
#pragma unroll
    for (int i = 0; i < 16; ++i) s_ += y[i];
    const float mean = wave_sum_fast(s_) * (1.f / 1024.f);
    float q = 0.f;
#pragma unroll
    for (int i = 0; i < 16; ++i) { y[i] -= mean; q += y[i] * y[i]; }
    const float rstd = rsqrtf(wave_sum_fast(q) * (1.f / 1024.f) + NORM_EPS);
    const int col = lane * 16;
    float r_[16];
#pragma unroll
    for (int i = 0; i < 16; ++i) r_[i] = y[i] * rstd * lng[col + i] + lnb[col + i];
    float* xo = Xout + (size_t)tok * 1024 + col;
#pragma unroll
    for (int i = 0; i < 4; ++i) *(float4*)(xo + 4 * i) = make_float4(r_[4 * i], r_[4 * i + 1], r_[4 * i + 2], r_[4 * i + 3]);
    {
      float am = 0.f;
#pragma unroll
      for (int i = 0; i < 16; ++i) am = fmaxf(am, fabsf(r_[i]));
      am = wave_max(am);
      const float sc = am > 0.f ? am * (1.f / 127.f) : 1.f;
      const float inv = 1.f / sc;
      u32x4 o8;
#pragma unroll
      for (int k = 0; k < 4; ++k) o8[k] = q8(r_[4 * k], inv, 0) | (q8(r_[4 * k + 1], inv, 0) << 8) | (q8(r_[4 * k + 2], inv, 0) << 16) | (q8(r_[4 * k + 3], inv, 0) << 24);
      *(u32x4*)(p.Xq8 + (size_t)tok * 1024 + col) = o8;
      if (lane == 0) p.sxq[tok] = sc;
    }
  }
}

DI void phase_ple(const Params& p, int layer, const float* X, const u16* Xb, float* Xout, u16* Xoutb, char* smem) {
  const u8* Wg8 = p.Wg8 + (size_t)layer * 1024 * 1024;
  const float* swl = p.swg + layer * 1024;
  const u16* pe = p.B2;
  TILE_LOOP(8) {
    const int p0 = nt_ * 128, q0 = mt_ * 128;
    f32x4 acc[4][4];
    {
      i32x4_t iacc[4][4];
#pragma unroll
      for (int a = 0; a < 4; ++a)
#pragma unroll
        for (int b = 0; b < 4; ++b) iacc[a][b] = i32x4_t{0, 0, 0, 0};
      gemm_core_i8(Wg8, 1024, p.Xq8, 1024, 1024, p0, q0, smem, iacc);
      const int lane = TIDX & 63, wave = TIDX >> 6;
      const int nb_ = p0 + (wave >> 1) * 64 + (lane >> 4) * 4, mb_ = q0 + (wave & 1) * 64 + (lane & 15);
#pragma unroll
      for (int a = 0; a < 4; ++a) {
        const float4 swv = *(const float4*)(swl + nb_ + a * 16);
#pragma unroll
        for (int b = 0; b < 4; ++b) {
          const float sxv = p.sxq[mb_ + b * 16];
          acc[a][b][0] = (float)iacc[a][b][0] * swv.x * sxv; acc[a][b][1] = (float)iacc[a][b][1] * swv.y * sxv;
          acc[a][b][2] = (float)iacc[a][b][2] * swv.z * sxv; acc[a][b][3] = (float)iacc[a][b][3] * swv.w * sxv;
        }
      }
    }
    EPI_BEGIN
      const size_t o_ = (size_t)qb_ * 1024 + pb_;
      const float4 xv = *(const float4*)(X + o_);
      const uint2 pv = *(const uint2*)(pe + o_);
      float4 o;
      o.x = xv.x + sigmoidf_(ev_[0]) * bflo(pv.x); o.y = xv.y + sigmoidf_(ev_[1]) * bfhi(pv.x);
      o.z = xv.z + sigmoidf_(ev_[2]) * bflo(pv.y); o.w = xv.w + sigmoidf_(ev_[3]) * bfhi(pv.y);
      *(float4*)(Xout + o_) = o;
      if (Xoutb) store4bf(Xoutb + o_, o.x, o.y, o.z, o.w);
    EPI_END
  }
}

DI void phase_mla_down(const Params& p, const u16* Xb, float* ckr, char* smem) {
  TILE_LOOP(6) {
    const int p0 = nt_ * 128, q0 = mt_ * 128;
    f32x4 acc[4][4]; zero_acc(acc);
    gemm_core(p.WdT, 1024, Xb, 1024, 1024, p0, q0, smem, acc);
    EPI_BEGIN
      *(f32x4*)(ckr + (size_t)qb_ * 768 + pb_) = ev_;
    EPI_END
  }
}
DI void phase_mla_norm(const Params& p, const float* ckr) {
  const int lane = TIDX & 63, wave = TIDX >> 6;
  for (int row = BIDX * 4 + wave; row < S; row += gridDim.x * 4) {
    const float* cr = ckr + (size_t)row * 768;
    const float4 a = *(const float4*)(cr + lane * 4);
    const float2 b0 = *(const float2*)(cr + 256 + lane * 6), b1 = *(const float2*)(cr + 256 + lane * 6 + 2), b2 = *(const float2*)(cr + 256 + lane * 6 + 4);
    const float kr = cr[640 + lane];
    const float ra = rsqrtf(wave_sum(a.x * a.x + a.y * a.y + a.z * a.z + a.w * a.w) * (1.f / 256.f) + NORM_EPS);
    const float rb = rsqrtf(wave_sum(b0.x * b0.x + b0.y * b0.y + b1.x * b1.x + b1.y * b1.y + b2.x * b2.x + b2.y * b2.y) * (1.f / 384.f) + NORM_EPS);
    store4bf(p.ckvb + (size_t)row * 256 + lane * 4, a.x * ra, a.y * ra, a.z * ra, a.w * ra);
    unsigned* cq = (unsigned*)(p.cqb + (size_t)row * 384 + lane * 6);
    cq[0] = pack2(b0.x * rb, b0.y * rb); cq[1] = pack2(b1.x * rb, b1.y * rb); cq[2] = pack2(b2.x * rb, b2.y * rb);
    const float other = __shfl_xor(kr, 32);
    const int f = lane & 31;
    const float cs = p.ropec[row * 32 + f], sn = p.ropes[row * 32 + f];
    const float o = (lane < 32) ? (kr * cs - other * sn) : (other * sn + kr * cs);
    p.krope[(size_t)row * 64 + lane] = f2bf(o);
  }
}

DI void phase_mla_up(const Params& p, char* smem) {
  u16* knope = p.B2; u16* vTa = p.B3; u16* qatt = p.B0;
  TILE_LOOP(28) {
    f32x4 acc[4][4]; zero_acc(acc);
    if (nt_ < 16) {
      const int hd = nt_ >> 1;
      if (nt_ & 1) {
        const int p0 = mt_ * 128, q0 = nt_ * 128;
        gemm_core(p.ckvb, 256, p.WupT, 256, 256, p0, q0, smem, acc);
        EPI_BEGIN
          store4bf(vTa + (size_t)(hd * 128 + qb_ - q0) * S + pb_, ev_[0], ev_[1], ev_[2], ev_[3]);
        EPI_END
      } else {
        const int p0 = nt_ * 128, q0 = mt_ * 128;
        gemm_core(p.WupT, 256, p.ckvb, 256, 256, p0, q0, smem, acc);
        EPI_BEGIN
          store4bf(knope + (size_t)qb_ * 1024 + hd * 128 + pb_ - p0, ev_[0], ev_[1], ev_[2], ev_[3]);
        EPI_END
      }
    } else {
      const int p0 = (nt_ - 16) * 128, q0 = mt_ * 128;
      gemm_core(p.WuqT, 384, p.cqb, 384, 384, p0, q0, smem, acc);
      EPI_BEGIN
        const int grp = pb_ >> 6;
        const int w_ = pb_ & 63;
        if ((grp % 3) == 2) {
          if (w_ < 32) {
            const f32x4 x2 = *(const f32x4*)((const float*)smem + er_ * 132 + ec_ + 32);
            const float4 cs = *(const float4*)(p.ropec + (size_t)qb_ * 32 + w_), sn = *(const float4*)(p.ropes + (size_t)qb_ * 32 + w_);
            store4bf(qatt + (size_t)qb_ * 1536 + pb_, ev_[0] * cs.x - x2[0] * sn.x, ev_[1] * cs.y - x2[1] * sn.y,
                     ev_[2] * cs.z - x2[2] * sn.z, ev_[3] * cs.w - x2[3] * sn.w);
            store4bf(qatt + (size_t)qb_ * 1536 + pb_ + 32, ev_[0] * sn.x + x2[0] * cs.x, ev_[1] * sn.y + x2[1] * cs.y,
                     ev_[2] * sn.z + x2[2] * cs.z, ev_[3] * sn.w + x2[3] * cs.w);
          }
        } else {
          store4bf(qatt + (size_t)qb_ * 1536 + pb_, ev_[0], ev_[1], ev_[2], ev_[3]);
        }
      EPI_END
    }
  }
}

DI void phase_attn(const Params& p, char* smem) {
  const u16* knope = p.B2; const u16* vTa = p.B3; const u16* qatt = p.B0; u16* oatt = p.B4;
  u16* sK = (u16*)smem;
  u16* sV = (u16*)(smem + 64 * 400);
  const int tid = TIDX, lane = tid & 63, wave = tid >> 6;
  const int r = lane & 31, hh = lane >> 5;
  for (int pi = BIDX; pi < 512; pi += gridDim.x) {
    const int h = pi & 7, jj = pi >> 3;
    for (int half = 0; half < 2; ++half) {
      const int qb = half ? jj : 127 - jj;
      const int q0 = qb * 128 + wave * 32;
      const int qpos = q0 + r;
      bf16x8 qf[12];
      {
        const u16* qp = qatt + (size_t)qpos * 1536 + h * 192 + hh * 8;
#pragma unroll
        for (int ks = 0; ks < 12; ++ks) qf[ks] = *(const bf16x8*)(qp + ks * 16);
      }
      f32x16 O[4];
#pragma unroll
      for (int mt = 0; mt < 4; ++mt)
#pragma unroll
        for (int i = 0; i < 16; ++i) O[mt][i] = 0.f;
      float m = -INFINITY, l = 0.f;
      const int ntiles = (qb + 1) * 2;
      const u16* knb = knope + h * 128;
      const u16* vtb = vTa + (size_t)h * 128 * S;
      const int offn = (tid >> 4) * 1024 + (tid & 15) * 8;
      const int offr = (tid >> 3) * 64 + (tid & 7) * 8;
      const int offv = (tid >> 3) * S + (tid & 7) * 8;
      u16* dKn = sK + (tid >> 4) * 200 + (tid & 15) * 8;
      u16* dKr = sK + (tid >> 3) * 200 + 128 + (tid & 7) * 8;
      u16* dV = sV + (tid >> 3) * 68 + (tid & 7) * 8;
      for (int t = 0; t < ntiles; ++t) {
        __syncthreads();
        {
          const int k0 = t * 64;
          u32x4 rk[6], rv[4];
#pragma unroll
          for (int i = 0; i < 4; ++i) rk[i] = *(const u32x4*)((knb + (size_t)(k0 + 16 * i) * 1024) + offn);
#pragma unroll
          for (int i = 0; i < 2; ++i) rk[4 + i] = *(const u32x4*)((p.krope + (size_t)(k0 + 32 * i) * 64) + offr);
#pragma unroll
          for (int i = 0; i < 4; ++i) rv[i] = *(const u32x4*)((vtb + (size_t)(32 * i) * S + k0) + offv);
#pragma unroll
          for (int i = 0; i < 4; ++i) *(u32x4*)(dKn + i * 16 * 200) = rk[i];
#pragma unroll
          for (int i = 0; i < 2; ++i) *(u32x4*)(dKr + i * 32 * 200) = rk[4 + i];
#pragma unroll
          for (int i = 0; i < 4; ++i) {
            u32x2* d = (u32x2*)(dV + i * 32 * 68);
            d[0] = u32x2{rv[i][0], rv[i][1]}; d[1] = u32x2{rv[i][2], rv[i][3]};
          }
        }
        __syncthreads();
        const int k0 = t * 64;
        const bool active = (k0 <= q0 + 31);
        f32x16 X[2];
        if (active) {
#pragma unroll
          for (int st = 0; st < 2; ++st) {
#pragma unroll
            for (int i = 0; i < 16; ++i) X[st][i] = 0.f;
#pragma unroll
            for (int ks = 0; ks < 12; ++ks) {
              X[st] = mfma32(*(const bf16x8*)(sK + (st * 32 + r) * 200 + ks * 16 + hh * 8), qf[ks], X[st]);
            }
          }
        }
        if (active) {
          if (k0 + 63 > q0) {
#pragma unroll
            for (int st = 0; st < 2; ++st)
#pragma unroll
              for (int i = 0; i < 16; ++i) {
                const int key = k0 + st * 32 + crow(i, hh);
                if (key > qpos) X[st][i] = -INFINITY;
              }
          }
          float mx = -INFINITY;
#pragma unroll
          for (int st = 0; st < 2; ++st)
#pragma unroll
            for (int i = 0; i < 16; ++i) mx = fmaxf(mx, X[st][i]);
          { const auto sw = __builtin_amdgcn_permlane32_swap(__float_as_uint(mx), __float_as_uint(mx), false, false); mx = fmaxf(__uint_as_float(sw[0]), __uint_as_float(sw[1])); }
          const float mn = fmaxf(m, mx);
          const float alpha = __builtin_amdgcn_exp2f(m - mn);
          m = mn;
          float ps = 0.f;
#pragma unroll
          for (int st = 0; st < 2; ++st)
#pragma unroll
            for (int i = 0; i < 16; ++i) { X[st][i] = __builtin_amdgcn_exp2f(X[st][i] - mn); ps += X[st][i]; }
          l = l * alpha + ps;
          if (__builtin_amdgcn_ballot_w64(alpha != 1.f) != 0ull) {
#pragma unroll
            for (int mt = 0; mt < 4; ++mt)
#pragma unroll
              for (int i = 0; i < 16; ++i) O[mt][i] *= alpha;
          }
#pragma unroll
          for (int st = 0; st < 2; ++st)
#pragma unroll
            for (int k2 = 0; k2 < 2; ++k2) {
              const bf16x8 pf = pack8(X[st][8 * k2 + 0], X[st][8 * k2 + 1], X[st][8 * k2 + 2], X[st][8 * k2 + 3],
                                      X[st][8 * k2 + 4], X[st][8 * k2 + 5], X[st][8 * k2 + 6], X[st][8 * k2 + 7]);
#pragma unroll
              for (int mt = 0; mt < 4; ++mt) {
                const u16* vp = sV + (mt * 32 + r) * 68 + st * 32 + k2 * 16 + hh * 4;
                const s16x4 lo = *(const s16x4*)vp, hi = *(const s16x4*)(vp + 8);
                O[mt] = mfma32(__builtin_shufflevector(lo, hi, 0, 1, 2, 3, 4, 5, 6, 7), pf, O[mt]);
              }
            }
        }
      }
      l += __shfl_xor(l, 32);
      const float inv = 1.f / l;
#pragma unroll
      for (int mt = 0; mt < 4; ++mt)
#pragma unroll
        for (int g4 = 0; g4 < 4; ++g4) {
          const int dv = mt * 32 + 8 * g4 + 4 * hh;
          store4bf(oatt + (size_t)qpos * 1024 + h * 128 + dv, O[mt][4 * g4] * inv, O[mt][4 * g4 + 1] * inv,
                   O[mt][4 * g4 + 2] * inv, O[mt][4 * g4 + 3] * inv);
        }
    }
  }
}

DI void run_phase(int ph, const Params& p, char* smem) {
  switch (ph) {
    case 0: phase_prologue(p, smem); break;
    case 1: phase_inproj(p, smem); break;
    case 2: phase_ml_local(p, smem); break;
    case 3: phase_ml_scan(p); break;
    case 4: phase_ml_out(p, smem); break;
    case 5: phase_outproj(p, 0, p.B0, p.WoaT, p.x, p.F1, smem); break;
    case 6: phase_ln(p.F1, p.B0, p.ln_g, p.ln_b, p.Xq8, p.sxq); break;
    case 7: phase_peer_query(p, 0, p.B0, smem); break;
    case 8: phase_peer_u(p, 0, p.F1, smem); break;
    case 20: phase_peer_v(p, 0, p.F1, p.F2, p.ln_g + 1024, p.ln_b + 1024, smem); break;
    case 9: phase_ple(p, 0, p.F2, p.B1, p.F2, p.B0, smem); break;
    case 10: phase_mla_down(p, p.B0, p.F1, smem); break;
    case 11: phase_mla_norm(p, p.F1); break;
    case 12: phase_mla_up(p, smem); break;
    case 13: phase_attn(p, smem); break;
    case 14: phase_outproj(p, 1, p.B4, p.WobT, p.F2, p.F2, smem); break;
    case 15: phase_ln(p.F2, p.B1, p.ln_g + 2048, p.ln_b + 2048, p.Xq8, p.sxq); break;
    case 16: phase_peer_query(p, 1, p.B1, smem); break;
    case 17: phase_peer_u(p, 1, p.F2, smem); break;
    case 21: phase_peer_v(p, 1, p.F2, p.F1, p.ln_g + 3072, p.ln_b + 3072, smem); break;
    case 18: phase_ple(p, 1, p.F1, p.B0, p.out, nullptr, smem); break;
    default: break;
  }
}


#define XB_TMO      128
#define XB_XCNT(j)  (256  + 64 * (j))
#define XB_XSUB(j)  (1280 + 64 * (j))
#define XB_XGEN(j)  (2304 + 64 * (j))
#define XB_TOP      3328
#define XB_TOPGEN   3392
#define XCD_BAR_WORDS 3456
#define XB_SPIN_CAP (1u << 22)
#define LAS __attribute__((address_space(3)))
DI unsigned xb_ld(unsigned* p) { return __hip_atomic_load(p, __ATOMIC_RELAXED, __HIP_MEMORY_SCOPE_AGENT); }
DI unsigned xb_add(unsigned* p, unsigned v) { return __hip_atomic_fetch_add(p, v, __ATOMIC_RELAXED, __HIP_MEMORY_SCOPE_AGENT); }
DI unsigned xb_xcc_id() { return (unsigned)__builtin_amdgcn_s_getreg((3 << 11) | 20) & 0xFu; }
#define XB_SPIN(cond, bar) do { unsigned _sp = 0; while (cond) { __builtin_amdgcn_s_sleep(1); \
    if ((++_sp & 255u) == 0u) { if (xb_ld(&(bar)[XB_TMO])) break; if (_sp > XB_SPIN_CAP) { atomicAdd(&(bar)[XB_TMO], 1u); break; } } } } while (0)
struct XcdBarrier { unsigned* bar; unsigned x; volatile LAS unsigned* st; };
DI XcdBarrier xcd_barrier_post(unsigned* bar, volatile LAS unsigned* st) {
  XcdBarrier b; b.bar = bar; b.x = xb_xcc_id(); b.st = st;
  if (TIDX == 0) (void)xb_add(&bar[XB_XCNT(b.x)], 1u);
  return b;
}
DI void xcd_barrier_complete(unsigned* bar, unsigned x, unsigned& nloc, unsigned& nx) {
  const unsigned G = gridDim.x * gridDim.y * gridDim.z;
  unsigned sum, cnt, mine, sp = 0u;
  for (;;) {
    sum = 0u; cnt = 0u; mine = 0u;
#pragma unroll
    for (unsigned j = 0; j < 16; ++j) { const unsigned c = xb_ld(&bar[XB_XCNT(j)]); sum += c; cnt += (c > 0u) ? 1u : 0u; mine = (j == x) ? c : mine; }
    if (sum == G) break;
    __builtin_amdgcn_s_sleep(1);
    if ((++sp & 255u) == 0u) { if (xb_ld(&bar[XB_TMO])) break; if (sp > XB_SPIN_CAP) { atomicAdd(&bar[XB_TMO], 1u); break; } }
  }
  nloc = mine > 0u ? mine : 1u; nx = cnt > 0u ? cnt : 1u;
}
DI void xcd_barrier(const XcdBarrier& b) {
  asm volatile("s_waitcnt vmcnt(0)" ::: "memory");
  __syncthreads();
  if (TIDX == 0) {
    unsigned* bar = b.bar;
    __builtin_amdgcn_s_waitcnt(0);
    unsigned nloc = b.st[0], nx = b.st[1];
    if (nloc == 0u) { xcd_barrier_complete(bar, b.x, nloc, nx); b.st[0] = nloc; b.st[1] = nx; }
    const unsigned old = xb_add(&bar[XB_XSUB(b.x)], 1u);
    const unsigned gen = old / nloc;
    if (old + 1u == (gen + 1u) * nloc) {
      __builtin_amdgcn_fence(__ATOMIC_RELEASE, "agent");
      asm volatile("s_waitcnt vmcnt(0)" ::: "memory");
      const unsigned og = xb_add(&bar[XB_TOP], 1u);
      const unsigned tg = og / nx;
      if (og + 1u == (tg + 1u) * nx) xb_add(&bar[XB_TOPGEN], 1u);
      else XB_SPIN(xb_ld(&bar[XB_TOPGEN]) == tg, bar);
      __builtin_amdgcn_fence(__ATOMIC_ACQUIRE, "agent");
      xb_add(&bar[XB_XGEN(b.x)], 1u);
      asm volatile("s_waitcnt vmcnt(0)" ::: "memory");
    } else {
      XB_SPIN(xb_ld(&bar[XB_XGEN(b.x)]) == gen, bar);
      __builtin_amdgcn_fence(__ATOMIC_ACQUIRE, "agent");
      asm volatile("s_waitcnt vmcnt(0)" ::: "memory");
    }
  }
  __syncthreads();
}

#ifndef DUP_MASK
#define DUP_MASK 0u
#endif
#define RUNP(k) { run_phase(k, p, smem); xcd_barrier(xb); if ((DUP_MASK >> (k)) & 1u) { run_phase(k, p, smem); xcd_barrier(xb); } }
#if MEGA
__global__ void __launch_bounds__(256, 2) mega_kernel(Params p) {
  __shared__ __attribute__((aligned(16))) char smem[SMEM_BYTES];
  __shared__ uint4 xb_words;
  cg::grid_group grid = cg::this_grid();
  if (TIDX == 0) xb_words = make_uint4(0u, 0u, 0u, 0u);
  __syncthreads();
  XcdBarrier xb = xcd_barrier_post(p.bar, (volatile LAS unsigned*)&xb_words);
  if (p.out == nullptr) grid.sync();
  RUNP(0) RUNP(1)
  RUNP(2) RUNP(3) RUNP(4) RUNP(5) RUNP(6) RUNP(7) RUNP(8) RUNP(20) RUNP(9)
  RUNP(10) RUNP(11) RUNP(12) RUNP(13) RUNP(14) RUNP(15) RUNP(16) RUNP(17) RUNP(21)
  run_phase(18, p, smem);
}
#else
__global__ void __launch_bounds__(256, 2) phase_kernel(Params p, int ph) {
  __shared__ __attribute__((aligned(16))) char smem[SMEM_BYTES];
  run_phase(ph, p, smem);
}
#endif

extern "C" void kernel_launch(void* const* d_in, const int* in_sizes, int n_in, void* d_out, int out_size, void* d_ws,
                              size_t ws_size, hipStream_t stream) {
  Params p{};
  p.x = (const float*)d_in[0]; p.p = (const float*)d_in[1]; p.pos = (const int*)d_in[2];
  p.ln_g = (const float*)d_in[3]; p.ln_b = (const float*)d_in[4]; p.a_w_in = (const float*)d_in[5];
  p.a_b_if = (const float*)d_in[6]; p.a_hn_g = (const float*)d_in[7]; p.a_w_out = (const float*)d_in[8];
  p.kv_w_down = (const float*)d_in[9]; p.kv_norm_g = (const float*)d_in[10]; p.kv_w_up = (const float*)d_in[11];
  p.b_w_dq = (const float*)d_in[12]; p.b_q_norm_g = (const float*)d_in[13]; p.b_w_uq = (const float*)d_in[14];
  p.b_w_out = (const float*)d_in[15]; p.peer_w_q = (const float*)d_in[16]; p.peer_sub_keys = (const float*)d_in[17];
  p.peer_u = (const float*)d_in[18]; p.peer_v = (const float*)d_in[19]; p.ple_w_proj = (const float*)d_in[20];
  p.ple_w_gate = (const float*)d_in[21];
  p.out = (float*)d_out;
  char* w = (char*)d_ws;
  size_t off = 0;
  auto take = [&](size_t bytes) { char* r = w + off; off += (bytes + 255) & ~(size_t)255; return r; };
  const size_t MB = 1024 * 1024;
  p.WinT = (u16*)take((size_t)3200 * 1024 * 2);
  p.WoaT = (u16*)take(2 * MB);
  p.WpqT = (u16*)take(8 * MB);
  p.SubK = (u16*)take(1 * MB);
  p.WgT = (u16*)take(4 * MB);
  p.WpT = (u16*)take(1 * MB);
  p.WdT = (u16*)take((size_t)768 * 1024 * 2);
  p.WupT = (u16*)take(1 * MB);
  p.WuqT = (u16*)take((size_t)1536 * 384 * 2);
  p.WobT = (u16*)take(2 * MB);
  p.Uq = (u8*)take(32 * MB);
  p.Vq = (u8*)take(32 * MB);
  p.scU = (float*)take(2 * 16384 * 4);
  p.scV = (float*)take(2 * 16384 * 4);
  p.Xq8 = (u8*)take((size_t)S * 1024);
  p.Wq8 = (u8*)take((size_t)2 * 2048 * 1024);
  p.sxq = (float*)take((size_t)S * 4);
  p.swq = (float*)take(2 * 2048 * 4);
  p.Wg8 = (u8*)take((size_t)2 * 1024 * 1024);
  p.swg = (float*)take(2 * 1024 * 4);
  p.Win8 = (u8*)take((size_t)3200 * 1024);
  p.swin = (float*)take(3200 * 4);
  p.pb = (u16*)take(16 * MB);
  p.F1 = (float*)take(64 * MB);
  p.F2 = (float*)take(64 * MB);
  p.B0 = (u16*)take(32 * MB);
  p.B1 = (u16*)take(32 * MB);
  p.B2 = (u16*)take(32 * MB);
  p.B3 = (u16*)take(32 * MB);
  p.B4 = (u16*)take(32 * MB);
  p.B6 = (u16*)take(16 * MB);
  p.igf = (float*)take((size_t)S * 8 * 4);
  p.lf = (float*)take((size_t)S * 8 * 4);
  p.dn = (float*)take((size_t)2048 * 64 * 4);
  p.nprev = (float*)take((size_t)2048 * 64 * 4);
  p.blast = (float*)take(2048 * 4);
  p.mloc = (float*)take(2048 * 4);
  p.mprev = (float*)take(2048 * 4);
  p.ropec = (float*)take((size_t)S * 32 * 4);
  p.ropes = (float*)take((size_t)S * 32 * 4);
  p.ckvb = (u16*)take((size_t)S * 256 * 2);
  p.cqb = (u16*)take((size_t)S * 384 * 2);
  p.krope = (u16*)take((size_t)S * 64 * 2);
  p.bar = (unsigned*)take(XCD_BAR_WORDS * 4);
  if (off > ws_size) { fprintf(stderr, "workspace too small: need %zu have %zu\n", off, ws_size); return; }
#if MEGA
  static int grid_blocks = 0;
  if (!grid_blocks) {
    int dev = 0, cus = 0, per_cu = 0;
    hipGetDevice(&dev);
    hipDeviceGetAttribute(&cus, hipDeviceAttributeMultiprocessorCount, dev);
    hipOccupancyMaxActiveBlocksPerMultiprocessor(&per_cu, mega_kernel, 256, 0);
    if (per_cu > 2) per_cu = 2;
    grid_blocks = cus * per_cu;
  }
  (void)hipMemsetAsync(p.bar, 0, XCD_BAR_WORDS * 4, stream);
  void* args[] = {&p};
  hipError_t e = hipLaunchCooperativeKernel((void*)mega_kernel, dim3(grid_blocks), dim3(256), args, 0, stream);
  if (e != hipSuccess) fprintf(stderr, "cooperative launch failed: %s (grid %d)\n", hipGetErrorString(e), grid_blocks);
#else
  for (int ph = 0; ph < 19; ++ph) hipLaunchKernelGGL(phase_kernel, dim3(512), dim3(256), 0, stream, p, ph);
#endif
}
```

```cpp
#include <hip/hip_runtime.h>
#include <hip/hip_cooperative_groups.h>
#include <stdint.h>
#include <cstdio>
namespace cg = cooperative_groups;

#ifndef MEGA
#define MEGA 1
#endif

#define DI __device__ __forceinline__
typedef unsigned short u16;
typedef short bf16x8 __attribute__((ext_vector_type(8)));
typedef short s16x4 __attribute__((ext_vector_type(4)));
typedef float f32x4 __attribute__((ext_vector_type(4)));
typedef float f32x16 __attribute__((ext_vector_type(16)));
typedef float f32x2 __attribute__((ext_vector_type(2)));
typedef unsigned u32x4 __attribute__((ext_vector_type(4)));
typedef unsigned u32x2 __attribute__((ext_vector_type(2)));
typedef int i32x4 __attribute__((ext_vector_type(4)));
typedef unsigned char u8;
typedef __bf16 bf2_t __attribute__((ext_vector_type(2)));

constexpr int S = 16384;
constexpr int D = 1024;
constexpr float NORM_EPS = 1e-5f;
constexpr float DN_ALPHA = 1.41421356237309515f;
constexpr int SMEM_BYTES = 73728;
constexpr int NPHASE = 20;

struct Params {
  const float *x, *p; const int* pos;
  const float *ln_g, *ln_b, *a_w_in, *a_b_if, *a_hn_g, *a_w_out, *kv_w_down, *kv_norm_g, *kv_w_up,
      *b_w_dq, *b_q_norm_g, *b_w_uq, *b_w_out, *peer_w_q, *peer_sub_keys, *peer_u, *peer_v, *ple_w_proj, *ple_w_gate;
  float* out;
  u16 *WinT, *WoaT, *WpqT, *SubK, *WgT, *WpT, *WdT, *WupT, *WuqT, *WobT, *pb;
  u8 *Uq, *Vq; float *scU, *scV;
  u8 *Xq8, *Wq8, *Wg8, *Win8; float *sxq, *swq, *swg, *swin;
  float *F1, *F2;
  u16 *B0, *B1, *B2, *B3, *B4, *B6;
  float *igf, *lf, *dn, *nprev, *blast, *mloc, *mprev, *ropec, *ropes;
  u16 *ckvb, *cqb, *krope;
  unsigned* bar;
};

DI int opaque_tid() { int t = threadIdx.x; asm volatile("" : "+v"(t)); return t; }
DI int opaque_bid() { int b = blockIdx.x; asm volatile("" : "+s"(b)); return b; }
#define TIDX opaque_tid()
#define BIDX opaque_bid()
DI unsigned pack2(float a, float b) { f32x2 v = {a, b}; bf2_t r = __builtin_convertvector(v, bf2_t); return __builtin_bit_cast(unsigned, r); }
DI u16 f2bf(float a) { return (u16)(pack2(a, 0.f) & 0xffffu); }
DI float bflo(unsigned u) { return __uint_as_float(u << 16); }
DI float bfhi(unsigned u) { return __uint_as_float(u & 0xffff0000u); }
DI float bf2f(u16 v) { return __uint_as_float(((unsigned)v) << 16); }
DI f32x4 mfma16(bf16x8 a, bf16x8 b, f32x4 c) { return __builtin_amdgcn_mfma_f32_16x16x32_bf16(a, b, c, 0, 0, 0); }
DI f32x16 mfma32(bf16x8 a, bf16x8 b, f32x16 c) { return __builtin_amdgcn_mfma_f32_32x32x16_bf16(a, b, c, 0, 0, 0); }
DI int crow(int i, int hh) { return (i & 3) + 8 * (i >> 2) + 4 * hh; }
DI float wave_sum(float v) {
#pragma unroll
  for (int o = 32; o; o >>= 1) v += __shfl_xor(v, o);
  return v;
}
DI float wave_max(float v) {
#pragma unroll
  for (int o = 32; o; o >>= 1) v = fmaxf(v, __shfl_xor(v, o));
  return v;
}
DI float sigmoidf_(float x) { return 1.f / (1.f + __expf(-x)); }
DI float logsigmoidf_(float x) { return fminf(x, 0.f) - log1pf(__expf(-fabsf(x))); }
DI bf16x8 pack8(float a0, float a1, float a2, float a3, float a4, float a5, float a6, float a7) {
  uint4 u; u.x = pack2(a0, a1); u.y = pack2(a2, a3); u.z = pack2(a4, a5); u.w = pack2(a6, a7);
  return __builtin_bit_cast(bf16x8, u);
}

DI void tconv_tile(const float* __restrict__ src, int lds, int K, int c0, int nc, u16* __restrict__ dst, int r0,
                   const float* __restrict__ g, float sc, int ti, char* smem) {
  float (*t)[65] = (float (*)[65])smem;
  const int tid = TIDX;
  const int nct = (nc + 63) / 64;
  const int kt = ti / nct, ct = ti % nct;
  __syncthreads();
#pragma unroll
  for (int r = 0; r < 16; ++r) {
    const int k = r * 4 + (tid >> 6), n = tid & 63;
    const int col = ct * 64 + n;
    float v = 0.f;
    if (col < nc) v = src[(size_t)(kt * 64 + k) * lds + c0 + col];
    if (g) v *= g[kt * 64 + k];
    t[k][n] = v * sc;
  }
  __syncthreads();
#pragma unroll
  for (int r = 0; r < 16; ++r) {
    const int n = r * 4 + (tid >> 6), k = tid & 63;
    const int col = ct * 64 + n;
    if (col < nc) dst[(size_t)(r0 + col) * K + kt * 64 + k] = f2bf(t[k][n]);
  }
}
DI void cvt_job(const float* __restrict__ src, u16* __restrict__ dst, size_t n) {
  const size_t n4 = n >> 2;
  const size_t stride = (size_t)gridDim.x * 256;
  for (size_t i = (size_t)BIDX * 256 + TIDX; i < n4; i += stride * 8) {
    float4 v[8];
#pragma unroll
    for (int u = 0; u < 8; ++u) if (i + u * stride < n4) { const f32x4 t_ = __builtin_nontemporal_load((const f32x4*)src + i + u * stride); v[u] = make_float4(t_[0], t_[1], t_[2], t_[3]); }
#pragma unroll
    for (int u = 0; u < 8; ++u) if (i + u * stride < n4) {
      uint2 o; o.x = pack2(v[u].x, v[u].y); o.y = pack2(v[u].z, v[u].w);
      ((uint2*)dst)[i + u * stride] = o;
    }
  }
}
DI void zero_job(u16* __restrict__ dst, size_t n) {
  for (size_t i = (size_t)BIDX * 256 + TIDX; i < n; i += (size_t)gridDim.x * 256) dst[i] = 0;
}

DI unsigned q8(float v, float inv, int bias) { int q = (int)rintf(v * inv); q = q < -127 ? -127 : (q > 127 ? 127 : q); return (unsigned)(q + bias) & 0xffu; }
DI unsigned q8x4(float4 v, float inv, int bias) { return q8(v.x, inv, bias) | (q8(v.y, inv, bias) << 8) | (q8(v.z, inv, bias) << 16) | (q8(v.w, inv, bias) << 24); }
DI float absmax4(float4 v) { return fmaxf(fmaxf(fabsf(v.x), fabsf(v.y)), fmaxf(fabsf(v.z), fabsf(v.w))); }
DI void quant_rows(const float* __restrict__ src, u8* __restrict__ dst, float* __restrict__ scale, int nrows, int bias, int vb, int nvb) {
  const int lane = TIDX & 63, wave = TIDX >> 6;
  for (int row0 = vb * 4 + wave; row0 < nrows; row0 += nvb * 16) {
    float4 v[4][4];
#pragma unroll
    for (int u = 0; u < 4; ++u) {
      const int row = row0 + u * nvb * 4;
      if (row < nrows) {
        const f32x4* r = (const f32x4*)(src + (size_t)row * 1024 + lane * 16);
#pragma unroll
        for (int k = 0; k < 4; ++k) { const f32x4 t_ = __builtin_nontemporal_load(r + k); v[u][k] = make_float4(t_[0], t_[1], t_[2], t_[3]); }
      }
    }
#pragma unroll
    for (int u = 0; u < 4; ++u) {
      const int row = row0 + u * nvb * 4;
      if (row < nrows) {
        float mx = fmaxf(fmaxf(absmax4(v[u][0]), absmax4(v[u][1])), fmaxf(absmax4(v[u][2]), absmax4(v[u][3])));
        mx = wave_max(mx);
        const float sc = mx > 0.f ? mx * (1.f / 127.f) : 1.f;
        const float inv = 1.f / sc;
        u32x4 o; o[0] = q8x4(v[u][0], inv, bias); o[1] = q8x4(v[u][1], inv, bias); o[2] = q8x4(v[u][2], inv, bias); o[3] = q8x4(v[u][3], inv, bias);
        *(u32x4*)(dst + (size_t)row * 1024 + lane * 16) = o;
        if (lane == 0) scale[row] = sc;
      }
    }
  }
}

DI void wq_tile(const float* __restrict__ src, int lds, int c0, u8* __restrict__ dst, float* __restrict__ scale, int r0, float mult, int ti, char* smem) {
  float (*t)[17] = (float (*)[17])smem;
  float* red = (float*)(smem + 1024 * 17 * 4);
  const int tid = TIDX;
  const int n = tid & 15, kq = tid >> 4;
  __syncthreads();
  float mx = 0.f;
#pragma unroll 8
  for (int kk = 0; kk < 64; ++kk) {
    const int k = kk * 16 + kq;
    const float v = src[(size_t)k * lds + c0 + ti * 16 + n];
    t[k][n] = v;
    mx = fmaxf(mx, fabsf(v));
  }
  red[kq * 16 + n] = mx;
  __syncthreads();
  if (tid < 16) {
    float m2 = 0.f;
#pragma unroll
    for (int j = 0; j < 16; ++j) m2 = fmaxf(m2, red[j * 16 + tid]);
    const float sc = m2 > 0.f ? m2 * (1.f / 127.f) : 1.f;
    red[256 + tid] = 1.f / sc;
    scale[r0 + ti * 16 + tid] = sc * mult;
  }
  __syncthreads();
  {
    const int nn = tid >> 4, ks = (tid & 15) * 64;
    const float inv = red[256 + nn];
    u8* d = dst + (size_t)(r0 + ti * 16 + nn) * 1024 + ks;
#pragma unroll
    for (int j = 0; j < 4; ++j) {
      u32x4 o;
#pragma unroll
      for (int w = 0; w < 4; ++w) {
        const int k = ks + j * 16 + w * 4;
        o[w] = q8(t[k][nn], inv, 0) | (q8(t[k + 1][nn], inv, 0) << 8) | (q8(t[k + 2][nn], inv, 0) << 16) | (q8(t[k + 3][nn], inv, 0) << 24);
      }
      *(u32x4*)(d + j * 16) = o;
    }
  }
}

DI void quant_rows_bf16(const u16* __restrict__ src, u8* __restrict__ dst, float* __restrict__ scale, int nrows, int vb, int nvb) {
  const int lane = TIDX & 63, wave = TIDX >> 6;
  for (int row = vb * 4 + wave; row < nrows; row += nvb * 4) {
    const uint4 a = *(const uint4*)(src + (size_t)row * 1024 + lane * 16), b = *(const uint4*)(src + (size_t)row * 1024 + lane * 16 + 8);
    const float4 v0 = make_float4(bflo(a.x), bfhi(a.x), bflo(a.y), bfhi(a.y)), v1 = make_float4(bflo(a.z), bfhi(a.z), bflo(a.w), bfhi(a.w));
    const float4 v2 = make_float4(bflo(b.x), bfhi(b.x), bflo(b.y), bfhi(b.y)), v3 = make_float4(bflo(b.z), bfhi(b.z), bflo(b.w), bfhi(b.w));
    float mx = fmaxf(fmaxf(absmax4(v0), absmax4(v1)), fmaxf(absmax4(v2), absmax4(v3)));
    mx = wave_max(mx);
    const float sc = mx > 0.f ? mx * (1.f / 127.f) : 1.f;
    const float inv = 1.f / sc;
    u32x4 o; o[0] = q8x4(v0, inv, 0); o[1] = q8x4(v1, inv, 0); o[2] = q8x4(v2, inv, 0); o[3] = q8x4(v3, inv, 0);
    *(u32x4*)(dst + (size_t)row * 1024 + lane * 16) = o;
    if (lane == 0) scale[row] = sc;
  }
}

DI void phase_prologue(const Params& p, char* smem) {
#define TJOB(src, lds, K, c0, nc, dst, r0, g, sc) { const int nt__ = (((nc) + 63) / 64) * ((K) / 64); \
    if (ti >= base && ti < base + nt__) tconv_tile(src, lds, K, c0, nc, dst, r0, g, sc, ti - base, smem); base += nt__; }
  for (int ti = BIDX;; ti += gridDim.x) {
    int base = 0;
#define WJOB(c0, nc, r0, mult) { const int nt__ = (nc) / 16; \
    if (ti >= base && ti < base + nt__) wq_tile(p.a_w_in, 3088, c0, p.Win8, p.swin, r0, mult, ti - base, smem); base += nt__; }
    WJOB(0, 512, 0, 1.f)
    WJOB(512, 512, 512, 0.125f)
    WJOB(1024, 1024, 1024, 1.f)
    WJOB(2064, 1024, 2048, 1.f)
    WJOB(2048, 16, 3072, 1.f)
#undef WJOB
    TJOB(p.a_w_out, 1024, 1024, 0, 1024, p.WoaT, 0, nullptr, 1.f)
    TJOB(p.peer_w_q, 2048, 1024, 0, 2048, p.WpqT, 0, nullptr, 1.f)
    TJOB(p.peer_w_q + (size_t)1024 * 2048, 2048, 1024, 0, 2048, p.WpqT + (size_t)2048 * 1024, 0, nullptr, 1.f)
    TJOB(p.ple_w_gate, 1024, 1024, 0, 1024, p.WgT, 0, nullptr, 1.f)
    TJOB(p.ple_w_gate + (size_t)1024 * 1024, 1024, 1024, 0, 1024, p.WgT + (size_t)1024 * 1024, 0, nullptr, 1.f)
    TJOB(p.ple_w_proj, 1024, 256, 0, 1024, p.WpT, 0, nullptr, 1.f)
    TJOB(p.ple_w_proj + (size_t)256 * 1024, 1024, 256, 0, 1024, p.WpT + (size_t)1024 * 256, 0, nullptr, 1.f)
    TJOB(p.kv_w_down, 320, 1024, 0, 256, p.WdT, 0, nullptr, 1.f)
    TJOB(p.b_w_dq, 384, 1024, 0, 384, p.WdT, 256, nullptr, 1.f)
    TJOB(p.kv_w_down, 320, 1024, 256, 64, p.WdT, 640, nullptr, 1.f)
    TJOB(p.kv_w_up, 2048, 256, 0, 2048, p.WupT, 0, p.kv_norm_g, 1.f)
    TJOB(p.b_w_uq, 1536, 384, 0, 1536, p.WuqT, 0, p.b_q_norm_g, 0.07216878364870322f * 1.4426950408889634f)
    TJOB(p.b_w_out, 1024, 1024, 0, 1024, p.WobT, 0, nullptr, 1.f)
    if (ti >= base) break;
  }
#undef TJOB
  zero_job((u16*)(p.Win8 + (size_t)3088 * 1024), (size_t)112 * 512);
  for (int i = BIDX * 256 + TIDX; i < 112; i += gridDim.x * 256) p.swin[3088 + i] = 0.f;
  zero_job(p.WdT + (size_t)704 * 1024, (size_t)64 * 1024);
  cvt_job(p.peer_sub_keys, p.SubK, (size_t)2 * 8 * 2 * 128 * 128);
  quant_rows(p.x, p.Xq8, p.sxq, S, 0, BIDX, gridDim.x);
  cvt_job(p.p, p.pb, (size_t)2 * S * 256);
  for (int i = BIDX * 256 + TIDX; i < S * 32; i += gridDim.x * 256) {
    const int m = i >> 5, f = i & 31;
    const float invf = powf(10000.f, -(float)(2 * f) / 64.f);
    const float ang = (float)p.pos[m] * invf;
    const double a = (double)ang;
    const double n = rint(a * 0.63661977236758134308);
    double r = fma(-n, 1.57079632679489655800, a);
    r = fma(-n, 6.12323399573676603587e-17, r);
    const double r2 = r * r;
    double sn = r * (1.0 + r2 * (-1.0 / 6 + r2 * (1.0 / 120 + r2 * (-1.0 / 5040 + r2 * (1.0 / 362880 + r2 * (-1.0 / 39916800 + r2 * (1.0 / 6227020800.0)))))));
    double cs = 1.0 + r2 * (-0.5 + r2 * (1.0 / 24 + r2 * (-1.0 / 720 + r2 * (1.0 / 40320 + r2 * (-1.0 / 3628800 + r2 * (1.0 / 479001600.0 + r2 * (-1.0 / 87178291200.0)))))));
    const int q = ((int)n) & 3;
    double c2, s2;
    if (q == 0) { c2 = cs; s2 = sn; } else if (q == 1) { c2 = -sn; s2 = cs; } else if (q == 2) { c2 = -cs; s2 = -sn; } else { c2 = sn; s2 = -cs; }
    p.ropec[i] = (float)c2; p.ropes[i] = (float)s2;
  }
}

#define GLDS16(src, dst) __builtin_amdgcn_global_load_lds((const unsigned*)(src), (__attribute__((address_space(3))) unsigned*)(dst), 16, 0, 0)
DI void gemm_core(const u16* __restrict__ P, int ldp, const u16* __restrict__ Q, int ldq, int K, int p0, int q0,
                  char* smem, f32x4 (&acc)[4][4]) {
  const int tid = TIDX, lane = tid & 63, wave = tid >> 6;
  const int wp = wave >> 1, wq = wave & 1;
  const u16* pu = P + (size_t)p0 * ldp;
  const u16* qu = Q + (size_t)q0 * ldq;
  int offp[4], offq[4];
#pragma unroll
  for (int i = 0; i < 4; ++i) {
    const int row = wave * 32 + i * 8 + (lane >> 3);
    const int g = (lane & 7) ^ ((row >> 1) & 7);
    offp[i] = row * ldp + g * 8;
    offq[i] = row * ldq + g * 8;
  }
  const int swz = (lane & 15) >> 1;
  const int ra_base = (wp * 64 + (lane & 15)) * 128, rb_base = 16384 + (wq * 64 + (lane & 15)) * 128;
  const int KT = K >> 6;
  __syncthreads();
#pragma unroll
  for (int i = 0; i < 4; ++i) {
    GLDS16(pu + offp[i], smem + (wave * 4 + i) * 1024);
    GLDS16(qu + offq[i], smem + 16384 + (wave * 4 + i) * 1024);
  }
  for (int kt = 0; kt < KT; ++kt) {
    asm volatile("s_waitcnt vmcnt(0)" ::: "memory");
    __syncthreads();
    if (kt + 1 < KT) {
      char* sn = smem + ((kt + 1) & 1) * 32768;
#pragma unroll
      for (int i = 0; i < 4; ++i) {
        GLDS16(pu + (kt + 1) * 64 + offp[i], sn + (wave * 4 + i) * 1024);
        GLDS16(qu + (kt + 1) * 64 + offq[i], sn + 16384 + (wave * 4 + i) * 1024);
      }
    }
    const char* sc = smem + (kt & 1) * 32768;
#pragma unroll
    for (int ks = 0; ks < 2; ++ks) {
      bf16x8 fa[4], fb[4];
      const int gofs = ((ks * 4 + (lane >> 4)) ^ swz) * 16;
#pragma unroll
      for (int mt = 0; mt < 4; ++mt) fa[mt] = *(const bf16x8*)(sc + ra_base + mt * 2048 + gofs);
#pragma unroll
      for (int nt = 0; nt < 4; ++nt) fb[nt] = *(const bf16x8*)(sc + rb_base + nt * 2048 + gofs);
#pragma unroll
      for (int mt = 0; mt < 4; ++mt)
#pragma unroll
        for (int nt = 0; nt < 4; ++nt) acc[mt][nt] = mfma16(fa[mt], fb[nt], acc[mt][nt]);
    }
  }
  __syncthreads();
}
typedef int i32x4_t __attribute__((ext_vector_type(4)));
DI void gemm_core_i8(const u8* __restrict__ P, int ldp, const u8* __restrict__ Q, int ldq, int K, int p0, int q0,
                     char* smem, i32x4_t (&acc)[4][4]) {
  const int tid = TIDX, lane = tid & 63, wave = tid >> 6;
  const int wp = wave >> 1, wq = wave & 1;
  const u8* pu = P + (size_t)p0 * ldp;
  const u8* qu = Q + (size_t)q0 * ldq;
  int offp[4], offq[4];
#pragma unroll
  for (int i = 0; i < 4; ++i) {
    const int row = wave * 32 + i * 8 + (lane >> 3);
    const int g = (lane & 7) ^ ((row >> 1) & 7);
    offp[i] = row * ldp + g * 16;
    offq[i] = row * ldq + g * 16;
  }
  const int swz = (lane & 15) >> 1;
  const int ra_base = (wp * 64 + (lane & 15)) * 128, rb_base = 16384 + (wq * 64 + (lane & 15)) * 128;
  const int KT = K >> 7;
  __syncthreads();
#pragma unroll
  for (int i = 0; i < 4; ++i) {
    GLDS16(pu + offp[i], smem + (wave * 4 + i) * 1024);
    GLDS16(qu + offq[i], smem + 16384 + (wave * 4 + i) * 1024);
  }
  for (int kt = 0; kt < KT; ++kt) {
    asm volatile("s_waitcnt vmcnt(0)" ::: "memory");
    __syncthreads();
    if (kt + 1 < KT) {
      char* sn = smem + ((kt + 1) & 1) * 32768;
#pragma unroll
      for (int i = 0; i < 4; ++i) {
        GLDS16(pu + (kt + 1) * 128 + offp[i], sn + (wave * 4 + i) * 1024);
        GLDS16(qu + (kt + 1) * 128 + offq[i], sn + 16384 + (wave * 4 + i) * 1024);
      }
    }
    const char* sc = smem + (kt & 1) * 32768;
#pragma unroll
    for (int ks = 0; ks < 2; ++ks) {
      i32x4_t fa[4], fb[4];
      const int gofs = ((ks * 4 + (lane >> 4)) ^ swz) * 16;
#pragma unroll
      for (int mt = 0; mt < 4; ++mt) fa[mt] = *(const i32x4_t*)(sc + ra_base + mt * 2048 + gofs);
#pragma unroll
      for (int nt = 0; nt < 4; ++nt) fb[nt] = *(const i32x4_t*)(sc + rb_base + nt * 2048 + gofs);
#pragma unroll
      for (int mt = 0; mt < 4; ++mt)
#pragma unroll
        for (int nt = 0; nt < 4; ++nt) acc[mt][nt] = __builtin_amdgcn_mfma_i32_16x16x64_i8(fa[mt], fb[nt], acc[mt][nt], 0, 0, 0);
    }
  }
  __syncthreads();
}
DI void zero_acc(f32x4 (&acc)[4][4]) {
#pragma unroll
  for (int a = 0; a < 4; ++a)
#pragma unroll
    for (int b = 0; b < 4; ++b) acc[a][b] = f32x4{0.f, 0.f, 0.f, 0.f};
}
#define EPI_IDX                                                        \
  const int lane = TIDX & 63, wave = TIDX >> 6;          \
  const int pb_ = p0 + (wave >> 1) * 64 + (lane >> 4) * 4;             \
  const int qb_ = q0 + (wave & 1) * 64 + (lane & 15);

DI void store4bf(u16* dst, float a, float b, float c, float d) { uint2 o; o.x = pack2(a, b); o.y = pack2(c, d); *(uint2*)dst = o; }

DI void stage_acc(f32x4 (&acc)[4][4], char* smem) {
  const int t = TIDX, lane = t & 63, wave = t >> 6;
  float* st = (float*)smem;
  const int pl = (wave >> 1) * 64 + (lane >> 4) * 4, ql = (wave & 1) * 64 + (lane & 15);
#pragma unroll
  for (int a = 0; a < 4; ++a)
#pragma unroll
    for (int b = 0; b < 4; ++b) *(f32x4*)(st + (ql + b * 16) * 132 + pl + a * 16) = acc[a][b];
}
#define EPI_BEGIN                                                                                  \
  stage_acc(acc, smem);                                                                            \
  __syncthreads();                                                                                 \
  {                                                                                                \
    const int et_ = TIDX;                                                                          \
    _Pragma("unroll 4") for (int ej_ = 0; ej_ < 16; ++ej_) {                                       \
      const int er_ = (et_ >> 5) + 8 * ej_, ec_ = (et_ & 31) * 4;                                  \
      const f32x4 ev_ = *(const f32x4*)((const float*)smem + er_ * 132 + ec_);                     \
      const int pb_ = p0 + ec_, qb_ = q0 + er_;
#define EPI_END }}

struct TileIter { int band, j, G, MTB; };
DI TileIter tile_iter_init() {
  TileIter t;
  if ((gridDim.x & 7) == 0) { t.band = BIDX & 7; t.j = BIDX >> 3; t.G = gridDim.x >> 3; t.MTB = 16; }
  else { t.band = 0; t.j = BIDX; t.G = gridDim.x; t.MTB = 128; }
  return t;
}
DI bool tile_of(const TileIter& t, int q, int NT, int& mt, int& nt) {
  const int full = NT >> 3, rem = NT & 7;
  const int per_full = t.MTB * 8;
  const int ng = q / per_full;
  if (ng < full) {
    const int r = q - ng * per_full, mh = r >> 6, r2 = r & 63;
    nt = ng * 8 + (r2 >> 3); mt = t.band * t.MTB + mh * 8 + (r2 & 7);
    return true;
  }
  q -= full * per_full;
  if (rem == 0 || q >= t.MTB * rem) return false;
  nt = full * 8 + q % rem; mt = t.band * t.MTB + q / rem;
  return true;
}
#define TILE_LOOP(NT) const TileIter tit_ = tile_iter_init(); int mt_, nt_; for (int q_ = tit_.j; tile_of(tit_, q_, (NT), mt_, nt_); q_ += tit_.G)


DI void gemm_core2(const u16* __restrict__ P, int ldp, const u16* __restrict__ Q, int ldq, int K, int p0, int q0,
                   char* smem, f32x4 (&acc)[4][8]) {
  const int tid = TIDX, lane = tid & 63, wave = tid >> 6;
  const int wp = wave >> 1, wq = wave & 1;
  const u16* pu = P + (size_t)p0 * ldp;
  const u16* qu = Q + (size_t)q0 * ldq;
  const int gd = (lane & 3) ^ ((lane >> 4) & 3);
  int offp[2], offq[4];
#pragma unroll
  for (int i = 0; i < 2; ++i) offp[i] = ((wave * 2 + i) * 16 + (lane >> 2)) * ldp + gd * 8;
#pragma unroll
  for (int i = 0; i < 4; ++i) offq[i] = ((wave * 4 + i) * 16 + (lane >> 2)) * ldq + gd * 8;
  const int pos16 = ((lane >> 4) ^ ((lane >> 2) & 3)) * 16;
  const int ra_base = (wp * 64 + (lane & 15)) * 64 + pos16, rb_base = 8192 + (wq * 128 + (lane & 15)) * 64 + pos16;
  const int KT = K >> 5;
  auto issue = [&](int kt, int st) {
    char* sn = smem + st * 24576;
#pragma unroll
    for (int i = 0; i < 2; ++i) GLDS16(pu + kt * 32 + offp[i], sn + (wave * 2 + i) * 1024);
#pragma unroll
    for (int i = 0; i < 4; ++i) GLDS16(qu + kt * 32 + offq[i], sn + 8192 + (wave * 4 + i) * 1024);
  };
  __syncthreads();
  issue(0, 0); issue(1, 1);
  int st = 0;
  for (int kt = 0; kt < KT; ++kt) {
    if (kt + 1 < KT) asm volatile("s_waitcnt vmcnt(6)" ::: "memory");
    else asm volatile("s_waitcnt vmcnt(0)" ::: "memory");
    asm volatile("s_waitcnt lgkmcnt(0)" ::: "memory");
    __builtin_amdgcn_s_barrier();
    if (kt + 2 < KT) issue(kt + 2, st >= 1 ? st - 1 : 2);
    const char* sc = smem + st * 24576;
    bf16x8 fa[4], fb[8];
#pragma unroll
    for (int mt = 0; mt < 4; ++mt) fa[mt] = *(const bf16x8*)(sc + ra_base + mt * 1024);
#pragma unroll
    for (int nt = 0; nt < 8; ++nt) fb[nt] = *(const bf16x8*)(sc + rb_base + nt * 1024);
#pragma unroll
    for (int mt = 0; mt < 4; ++mt)
#pragma unroll
      for (int nt = 0; nt < 8; ++nt) acc[mt][nt] = mfma16(fa[mt], fb[nt], acc[mt][nt]);
    st = (st == 2) ? 0 : st + 1;
  }
  __syncthreads();
}
DI void zero_acc2(f32x4 (&acc)[4][8]) {
#pragma unroll
  for (int a = 0; a < 4; ++a)
#pragma unroll
    for (int b = 0; b < 8; ++b) acc[a][b] = f32x4{0.f, 0.f, 0.f, 0.f};
}
DI void stage_acc2(f32x4 (&acc)[4][8], char* smem, int half) {
  const int t = TIDX, lane = t & 63, wave = t >> 6;
  if ((wave & 1) != half) return;
  float* st = (float*)smem;
  const int pl = (wave >> 1) * 64 + (lane >> 4) * 4, ql = (lane & 15);
#pragma unroll
  for (int a = 0; a < 4; ++a)
#pragma unroll
    for (int b = 0; b < 8; ++b) *(f32x4*)(st + (ql + b * 16) * 132 + pl + a * 16) = acc[a][b];
}
#define EPI2_BEGIN                                                                                 \
  for (int eh_ = 0; eh_ < 2; ++eh_) {                                                              \
    __syncthreads();                                                                               \
    stage_acc2(acc, smem, eh_);                                                                    \
    __syncthreads();                                                                               \
    const int et_ = TIDX;                                                                          \
    _Pragma("unroll 4") for (int ej_ = 0; ej_ < 16; ++ej_) {                                       \
      const int er_ = (et_ >> 5) + 8 * ej_, ec_ = (et_ & 31) * 4;                                  \
      const f32x4 ev_ = *(const f32x4*)((const float*)smem + er_ * 132 + ec_);                     \
      const int pb_ = p0 + ec_, qb_ = q0 + eh_ * 128 + er_;
#define EPI2_END }}
#define TILE_LOOP2(NT) TileIter tit_ = tile_iter_init(); tit_.MTB >>= 1; int mt_, nt_; for (int q_ = tit_.j; tile_of(tit_, q_, (NT), mt_, nt_); q_ += tit_.G)

DI void phase_inproj(const Params& p, char* smem) {
  u16* q_ml = p.B2; u16* k_ml = p.B2 + (size_t)S * 512; u16* kT = p.B6; u16* vT = p.B3; u16* og = p.B4;
  TILE_LOOP(25) {
    f32x4 acc[4][4];
    i32x4_t iacc[4][4];
#pragma unroll
    for (int a = 0; a < 4; ++a)
#pragma unroll
      for (int b = 0; b < 4; ++b) iacc[a][b] = i32x4_t{0, 0, 0, 0};
    const int lane_ = TIDX & 63, wave_ = TIDX >> 6;
    if (nt_ >= 8 && nt_ < 16) {
      const int p0 = mt_ * 128, q0 = nt_ * 128;
      gemm_core_i8(p.Xq8, 1024, p.Win8, 1024, 1024, p0, q0, smem, iacc);
      const int mb_ = p0 + (wave_ >> 1) * 64 + (lane_ >> 4) * 4, nb_ = q0 + (wave_ & 1) * 64 + (lane_ & 15);
#pragma unroll
      for (int a = 0; a < 4; ++a) {
        const float4 sxv = *(const float4*)(p.sxq + mb_ + a * 16);
#pragma unroll
        for (int b = 0; b < 4; ++b) {
          const float swv = p.swin[nb_ + b * 16];
          acc[a][b][0] = (float)iacc[a][b][0] * sxv.x * swv; acc[a][b][1] = (float)iacc[a][b][1] * sxv.y * swv;
          acc[a][b][2] = (float)iacc[a][b][2] * sxv.z * swv; acc[a][b][3] = (float)iacc[a][b][3] * sxv.w * swv;
        }
      }
      EPI_BEGIN
        store4bf(vT + (size_t)(qb_ - 1024) * S + pb_, ev_[0], ev_[1], ev_[2], ev_[3]);
      EPI_END
    } else {
      const int p0 = nt_ * 128, q0 = mt_ * 128;
      gemm_core_i8(p.Win8, 1024, p.Xq8, 1024, 1024, p0, q0, smem, iacc);
      const int nb_ = p0 + (wave_ >> 1) * 64 + (lane_ >> 4) * 4, mb_ = q0 + (wave_ & 1) * 64 + (lane_ & 15);
#pragma unroll
      for (int a = 0; a < 4; ++a) {
        const float4 swv = *(const float4*)(p.swin + nb_ + a * 16);
#pragma unroll
        for (int b = 0; b < 4; ++b) {
          const float sxv = p.sxq[mb_ + b * 16];
          acc[a][b][0] = (float)iacc[a][b][0] * swv.x * sxv; acc[a][b][1] = (float)iacc[a][b][1] * swv.y * sxv;
          acc[a][b][2] = (float)iacc[a][b][2] * swv.z * sxv; acc[a][b][3] = (float)iacc[a][b][3] * swv.w * sxv;
        }
      }
      EPI_BEGIN
        const int n = pb_, m = qb_;
        if (nt_ < 4) {
          store4bf(q_ml + (size_t)m * 512 + n, ev_[0], ev_[1], ev_[2], ev_[3]);
        } else if (nt_ < 8) {
          store4bf(k_ml + (size_t)m * 512 + n - 512, ev_[0], ev_[1], ev_[2], ev_[3]);
        } else if (nt_ < 24) {
          store4bf(og + (size_t)m * 1024 + n - 2048, sigmoidf_(ev_[0]), sigmoidf_(ev_[1]), sigmoidf_(ev_[2]), sigmoidf_(ev_[3]));
        } else {
          const int nn = n - 3072;
          if (nn < 8) {
#pragma unroll
            for (int i = 0; i < 4; ++i) p.igf[m * 8 + nn + i] = ev_[i] + p.a_b_if[nn + i];
          } else if (nn < 16) {
#pragma unroll
            for (int i = 0; i < 4; ++i) p.lf[m * 8 + nn - 8 + i] = logsigmoidf_(ev_[i] + p.a_b_if[nn + i]);
          }
        }
      EPI_END
      if (nt_ >= 4 && nt_ < 8) {
        const int et = TIDX;
        const float* st = (const float*)smem;
#pragma unroll 4
        for (int ej = 0; ej < 16; ++ej) {
          const int nl = (et >> 5) + 8 * ej, ml = (et & 31) * 4;
          store4bf(kT + (size_t)(p0 - 512 + nl) * S + q0 + ml, st[ml * 132 + nl], st[(ml + 1) * 132 + nl], st[(ml + 2) * 132 + nl], st[(ml + 3) * 132 + nl]);
        }
      }
    }
  }
}


DI void phase_ml_local(const Params& p, char* smem) {
  float* sw = (float*)smem;
  const u16* kT = p.B6; const u16* vT = p.B3; float* dC = p.F2;
  const int tid = TIDX, lane = tid & 63, wave = tid >> 6;
  const int r = lane & 31, hh = lane >> 5;
  for (int it = BIDX; it < 2048; it += gridDim.x) {
    const int c = it >> 3, h = it & 7;
    __syncthreads();
    if (wave == 0) {
      const int t = c * 64 + lane;
      const float lfv = p.lf[t * 8 + h], igv = p.igf[t * 8 + h];
      float b = lfv;
#pragma unroll
      for (int o = 1; o < 64; o <<= 1) { float y = __shfl_up(b, o); if (lane >= o) b += y; }
      const float bl = __shfl(b, 63);
      const float ls = bl - b + igv;
      const float mx = wave_max(ls);
      sw[lane] = __expf(ls - mx);
      if (lane == 0) { p.blast[it] = bl; p.mloc[it] = mx; }
    }
    __syncthreads();
    f32x16 acc0, acc1;
#pragma unroll
    for (int i = 0; i < 16; ++i) { acc0[i] = 0.f; acc1[i] = 0.f; }
    const u16* va = vT + (size_t)(h * 128 + wave * 32 + r) * S + c * 64 + hh * 8;
    const u16* kb0 = kT + (size_t)(h * 64 + r) * S + c * 64 + hh * 8;
    const u16* kb1 = kb0 + (size_t)32 * S;
#pragma unroll
    for (int ks = 0; ks < 4; ++ks) {
      const bf16x8 a = *(const bf16x8*)(va + ks * 16);
      const uint4 k0 = *(const uint4*)(kb0 + ks * 16), k1 = *(const uint4*)(kb1 + ks * 16);
      const float* w = sw + ks * 16 + hh * 8;
      const bf16x8 b0 = pack8(bflo(k0.x) * w[0], bfhi(k0.x) * w[1], bflo(k0.y) * w[2], bfhi(k0.y) * w[3],
                              bflo(k0.z) * w[4], bfhi(k0.z) * w[5], bflo(k0.w) * w[6], bfhi(k0.w) * w[7]);
      const bf16x8 b1 = pack8(bflo(k1.x) * w[0], bfhi(k1.x) * w[1], bflo(k1.y) * w[2], bfhi(k1.y) * w[3],
                              bflo(k1.z) * w[4], bfhi(k1.z) * w[5], bflo(k1.w) * w[6], bfhi(k1.w) * w[7]);
      acc0 = mfma32(a, b0, acc0);
      acc1 = mfma32(a, b1, acc1);
    }
    float* dst = dC + (size_t)it * 8192;
#pragma unroll
    for (int i = 0; i < 16; ++i) {
      const int dv = wave * 32 + crow(i, hh);
      dst[dv * 64 + r] = acc0[i];
      dst[dv * 64 + 32 + r] = acc1[i];
    }
    if (tid < 64) {
      const u16* kr = kT + (size_t)(h * 64 + tid) * S + c * 64;
      float s = 0.f;
#pragma unroll
      for (int j = 0; j < 8; ++j) {
        const uint4 kk = *(const uint4*)(kr + j * 8);
        const float* w = sw + j * 8;
        s += bflo(kk.x) * w[0] + bfhi(kk.x) * w[1] + bflo(kk.y) * w[2] + bfhi(kk.y) * w[3] +
             bflo(kk.z) * w[4] + bfhi(kk.z) * w[5] + bflo(kk.w) * w[6] + bfhi(kk.w) * w[7];
      }
      p.dn[it * 64 + tid] = s;
    }
  }
}

DI void phase_ml_scan(const Params& p) {
  const float* __restrict__ dC = p.F2; u16* __restrict__ Cb = p.B1;
  const int total = 8 * 8256, half = total / 2;
  const int nscan = half / 256;
  const int bid = BIDX;
  const bool split = (int)gridDim.x > nscan + 32;
  if (split && bid >= nscan) {
    quant_rows(p.peer_u, p.Uq, p.scU, 2 * 16384, 0, bid - nscan, gridDim.x - nscan);
    quant_rows(p.peer_v, p.Vq, p.scV, 2 * 16384, 0, bid - nscan, gridDim.x - nscan);
    quant_rows_bf16(p.WpqT, p.Wq8, p.swq, 2 * 2048, bid - nscan, gridDim.x - nscan);
    quant_rows_bf16(p.WgT, p.Wg8, p.swg, 2 * 1024, bid - nscan, gridDim.x - nscan);
    return;
  }
  const int nsb = split ? nscan : (int)gridDim.x;
  for (int g = bid * 256 + TIDX; g < half; g += nsb * 256) {
    const int hA = g / 8256, eA = g % 8256, hB = hA + 4, eB = eA;
    const bool isC = eA < 8192;
    float mA = 0.f, CA = 0.f, mB = 0.f, CB = 0.f;
    for (int c0 = 0; c0 < 256; c0 += 8) {
      float dA[8], blA[8], mlA[8], dB[8], blB[8], mlB[8];
#pragma unroll
      for (int j = 0; j < 8; ++j) {
        const int itA = (c0 + j) * 8 + hA, itB = (c0 + j) * 8 + hB;
        dA[j] = isC ? dC[(size_t)itA * 8192 + eA] : p.dn[itA * 64 + eA - 8192];
        dB[j] = isC ? dC[(size_t)itB * 8192 + eB] : p.dn[itB * 64 + eB - 8192];
        blA[j] = p.blast[itA]; mlA[j] = p.mloc[itA];
        blB[j] = p.blast[itB]; mlB[j] = p.mloc[itB];
      }
#pragma unroll
      for (int j = 0; j < 8; ++j) {
        const int itA = (c0 + j) * 8 + hA, itB = (c0 + j) * 8 + hB;
        if (isC) { Cb[(size_t)itA * 8192 + eA] = f2bf(CA); Cb[(size_t)itB * 8192 + eB] = f2bf(CB); }
        else { p.nprev[itA * 64 + eA - 8192] = CA; p.nprev[itB * 64 + eB - 8192] = CB; }
        if (eA == 0) { p.mprev[itA] = mA; p.mprev[itB] = mB; }
        const float mnA = fmaxf(blA[j] + mA, mlA[j]);
        CA = __expf(blA[j] + mA - mnA) * CA + __expf(mlA[j] - mnA) * dA[j];
        mA = mnA;
        const float mnB = fmaxf(blB[j] + mB, mlB[j]);
        CB = __expf(blB[j] + mB - mnB) * CB + __expf(mlB[j] - mnB) * dB[j];
        mB = mnB;
      }
    }
  }
  if (!split) {
    quant_rows(p.peer_u, p.Uq, p.scU, 2 * 16384, 0, bid, gridDim.x);
    quant_rows(p.peer_v, p.Vq, p.scV, 2 * 16384, 0, bid, gridDim.x);
    quant_rows_bf16(p.WpqT, p.Wq8, p.swq, 2 * 2048, bid, gridDim.x);
    quant_rows_bf16(p.WgT, p.Wg8, p.swg, 2 * 1024, bid, gridDim.x);
  }
}

DI void phase_ml_out(const Params& p, char* smem) {
  const u16* q_ml = p.B2; const u16* k_ml = p.B2 + (size_t)S * 512; const u16* vT = p.B3; const u16* og = p.B4;
  const u16* Cb = p.B1; u16* hout = p.B0;
  const int tid = TIDX, lane = tid & 63, wave = tid >> 6;
  float* sA = (float*)smem + wave * 192;
  const int r = lane & 31, hh = lane >> 5;
  for (int bi = BIDX; bi < 1024; bi += gridDim.x) {
    const int it = bi * 2 + (wave >> 1), tt = wave & 1;
    const int c = it >> 3, h = it & 7;
    const float mprev = p.mprev[it];
    {
      const int t = c * 64 + lane;
      const float lfv = p.lf[t * 8 + h], igv = p.igf[t * 8 + h];
      float b = lfv;
#pragma unroll
      for (int o = 1; o < 64; o <<= 1) { float y = __shfl_up(b, o); if (lane >= o) b += y; }
      const float a = igv - b;
      float pm = a;
#pragma unroll
      for (int o = 1; o < 64; o <<= 1) { float y = __shfl_up(pm, o); if (lane >= o) pm = fmaxf(pm, y); }
      const float mt = fmaxf(b + mprev, b + pm);
      __syncthreads();
      sA[lane] = a; sA[64 + lane] = b; sA[128 + lane] = mt;
      __syncthreads();
    }
    const int tl = tt * 32 + r;
    const float b_t = sA[64 + tl], m_t = sA[128 + tl];
    const u16* qp = q_ml + (size_t)(c * 64 + tl) * 512 + h * 64 + hh * 8;
    bf16x8 qf[4];
#pragma unroll
    for (int ks = 0; ks < 4; ++ks) qf[ks] = *(const bf16x8*)(qp + ks * 16);
    f32x16 X[2];
    float den = 0.f;
#pragma unroll
    for (int st = 0; st < 2; ++st) {
#pragma unroll
      for (int i = 0; i < 16; ++i) X[st][i] = 0.f;
      if (st <= tt) {
        const u16* kp = k_ml + (size_t)(c * 64 + st * 32 + r) * 512 + h * 64 + hh * 8;
#pragma unroll
        for (int ks = 0; ks < 4; ++ks) X[st] = mfma32(*(const bf16x8*)(kp + ks * 16), qf[ks], X[st]);
#pragma unroll
        for (int i = 0; i < 16; ++i) {
          const int s = st * 32 + crow(i, hh);
          const float w = (s <= tl) ? __expf(b_t + sA[s] - m_t) : 0.f;
          X[st][i] *= w;
          den += X[st][i];
        }
      }
    }
    f32x16 acc[4];
    const u16* cp = Cb + (size_t)it * 8192 + (size_t)r * 64 + hh * 8;
#pragma unroll
    for (int mt = 0; mt < 4; ++mt) {
#pragma unroll
      for (int i = 0; i < 16; ++i) acc[mt][i] = 0.f;
#pragma unroll
      for (int ks = 0; ks < 4; ++ks) acc[mt] = mfma32(*(const bf16x8*)(cp + mt * 32 * 64 + ks * 16), qf[ks], acc[mt]);
    }
    const float s_inter = __expf(b_t + mprev - m_t);
#pragma unroll
    for (int mt = 0; mt < 4; ++mt)
#pragma unroll
      for (int i = 0; i < 16; ++i) acc[mt][i] *= s_inter;
    {
      float dq = 0.f;
      const float* np = p.nprev + it * 64 + hh * 8;
#pragma unroll
      for (int ks = 0; ks < 4; ++ks)
#pragma unroll
        for (int j = 0; j < 8; ++j) dq += bf2f((u16)qf[ks][j]) * np[ks * 16 + j];
      den += s_inter * dq;
    }
    den += __shfl_xor(den, 32);
#pragma unroll
    for (int st = 0; st < 2; ++st) {
      if (st <= tt) {
#pragma unroll
        for (int k2 = 0; k2 < 2; ++k2) {
          const bf16x8 pf = pack8(X[st][8 * k2 + 0], X[st][8 * k2 + 1], X[st][8 * k2 + 2], X[st][8 * k2 + 3],
                                  X[st][8 * k2 + 4], X[st][8 * k2 + 5], X[st][8 * k2 + 6], X[st][8 * k2 + 7]);
#pragma unroll
          for (int mt = 0; mt < 4; ++mt) {
            const u16* vp = vT + (size_t)(h * 128 + mt * 32 + r) * S + c * 64 + st * 32 + k2 * 16 + hh * 4;
            const s16x4 lo = *(const s16x4*)vp, hi = *(const s16x4*)(vp + 8);
            const bf16x8 a = __builtin_shufflevector(lo, hi, 0, 1, 2, 3, 4, 5, 6, 7);
            acc[mt] = mfma32(a, pf, acc[mt]);
          }
        }
      }
    }
    const float inv = 1.f / fmaxf(fabsf(den), __expf(-m_t));
    float sum = 0.f;
#pragma unroll
    for (int mt = 0; mt < 4; ++mt)
#pragma unroll
      for (int i = 0; i < 16; ++i) { acc[mt][i] *= inv; sum += acc[mt][i]; }
    sum += __shfl_xor(sum, 32);
    const float mean = sum * (1.f / 128.f);
    float vs = 0.f;
#pragma unroll
    for (int mt = 0; mt < 4; ++mt)
#pragma unroll
      for (int i = 0; i < 16; ++i) { const float dd = acc[mt][i] - mean; vs += dd * dd; }
    vs += __shfl_xor(vs, 32);
    const float rstd = rsqrtf(vs * (1.f / 128.f) + NORM_EPS);
    const size_t t = (size_t)c * 64 + tl;
#pragma unroll
    for (int mt = 0; mt < 4; ++mt)
#pragma unroll
      for (int g4 = 0; g4 < 4; ++g4) {
        const int col = h * 128 + mt * 32 + 8 * g4 + 4 * hh;
        const uint2 ogv = *(const uint2*)(og + t * 1024 + col);
        const float4 gv = *(const float4*)(p.a_hn_g + col);
        const float o0 = bflo(ogv.x) * (acc[mt][4 * g4 + 0] - mean) * rstd * gv.x;
        const float o1 = bfhi(ogv.x) * (acc[mt][4 * g4 + 1] - mean) * rstd * gv.y;
        const float o2 = bflo(ogv.y) * (acc[mt][4 * g4 + 2] - mean) * rstd * gv.z;
        const float o3 = bfhi(ogv.y) * (acc[mt][4 * g4 + 3] - mean) * rstd * gv.w;
        store4bf(hout + t * 1024 + col, o0, o1, o2, o3);
      }
  }
}

DI void phase_outproj(const Params& p, int layer, const u16* A, const u16* WT, const float* R, float* Y, char* smem) {
  const u16* WpT = p.WpT + (size_t)layer * 1024 * 256;
  const u16* pbl = p.pb + (size_t)layer * S * 256;
  u16* pe = p.B2;
  TILE_LOOP2(16) {
    f32x4 acc[4][8]; zero_acc2(acc);
    const int p0 = (nt_ & 7) * 128, q0 = mt_ * 256;
    if (nt_ < 8) {
      gemm_core2(WT, 1024, A, 1024, 1024, p0, q0, smem, acc);
      EPI2_BEGIN
        const float4 rv = *(const float4*)(R + (size_t)qb_ * 1024 + pb_);
        float4 o;
        o.x = DN_ALPHA * rv.x + ev_[0]; o.y = DN_ALPHA * rv.y + ev_[1];
        o.z = DN_ALPHA * rv.z + ev_[2]; o.w = DN_ALPHA * rv.w + ev_[3];
        *(float4*)(Y + (size_t)qb_ * 1024 + pb_) = o;
      EPI2_END
    } else {
      gemm_core2(WpT, 256, pbl, 256, 256, p0, q0, smem, acc);
      EPI2_BEGIN
        store4bf(pe + (size_t)qb_ * 1024 + pb_, ev_[0], ev_[1], ev_[2], ev_[3]);
      EPI2_END
    }
  }
}

DI void phase_ln(float* X, u16* Xb, const float* g, const float* bta, u8* Xq, float* sxs) {
  const int lane = TIDX & 63, wave = TIDX >> 6;
  for (int row = BIDX * 4 + wave; row < S; row += gridDim.x * 4) {
    float* xr = X + (size_t)row * 1024;
    float4 v[4];
#pragma unroll
    for (int i = 0; i < 4; ++i) v[i] = *(const float4*)(xr + i * 256 + lane * 4);
    float s = 0.f;
#pragma unroll
    for (int i = 0; i < 4; ++i) s += v[i].x + v[i].y + v[i].z + v[i].w;
    const float mean = wave_sum(s) * (1.f / 1024.f);
    float q = 0.f;
#pragma unroll
    for (int i = 0; i < 4; ++i) {
      v[i].x -= mean; v[i].y -= mean; v[i].z -= mean; v[i].w -= mean;
      q += v[i].x * v[i].x + v[i].y * v[i].y + v[i].z * v[i].z + v[i].w * v[i].w;
    }
    const float rstd = rsqrtf(wave_sum(q) * (1.f / 1024.f) + NORM_EPS);
    float amax = 0.f;
#pragma unroll
    for (int i = 0; i < 4; ++i) {
      const float4 gv = *(const float4*)(g + i * 256 + lane * 4), bv = *(const float4*)(bta + i * 256 + lane * 4);
      float4 o;
      o.x = v[i].x * rstd * gv.x + bv.x; o.y = v[i].y * rstd * gv.y + bv.y;
      o.z = v[i].z * rstd * gv.z + bv.z; o.w = v[i].w * rstd * gv.w + bv.w;
      *(float4*)(xr + i * 256 + lane * 4) = o;
      v[i] = o;
      amax = fmaxf(amax, absmax4(o));
    }
    amax = wave_max(amax);
    const float sc = amax > 0.f ? amax * (1.f / 127.f) : 1.f;
    const float inv = 1.f / sc;
#pragma unroll
    for (int i = 0; i < 4; ++i) *(unsigned*)(Xq + (size_t)row * 1024 + i * 256 + lane * 4) = q8x4(v[i], inv, 0);
    if (lane == 0) sxs[row] = sc;
  }
}

DI void phase_peer_query(const Params& p, int layer, const u16* Xb, char* smem) {
  const u16* WT = p.WpqT + (size_t)layer * 2048 * 1024;
  const u16* SK = p.SubK + (size_t)layer * 16 * 128 * 128;
  float* topk = (float*)p.B6;
  const int tid = TIDX, lane = tid & 63, wave = tid >> 6;
  TILE_LOOP(16) {
    const int slot = nt_;
    f32x4 acc[4][4];
    {
      const int p0 = slot * 128, q0 = mt_ * 128;
      i32x4_t iacc[4][4];
#pragma unroll
      for (int a = 0; a < 4; ++a)
#pragma unroll
        for (int b = 0; b < 4; ++b) iacc[a][b] = i32x4_t{0, 0, 0, 0};
      gemm_core_i8(p.Wq8 + (size_t)layer * 2048 * 1024, 1024, p.Xq8, 1024, 1024, p0, q0, smem, iacc);
      const int nb_ = p0 + (wave >> 1) * 64 + (lane >> 4) * 4, mb_ = q0 + (wave & 1) * 64 + (lane & 15);
      const float* swl = p.swq + layer * 2048;
#pragma unroll
      for (int a = 0; a < 4; ++a) {
        const float4 swv = *(const float4*)(swl + nb_ + a * 16);
#pragma unroll
        for (int b = 0; b < 4; ++b) {
          const float sxv = p.sxq[mb_ + b * 16];
          acc[a][b][0] = (float)iacc[a][b][0] * swv.x * sxv; acc[a][b][1] = (float)iacc[a][b][1] * swv.y * sxv;
          acc[a][b][2] = (float)iacc[a][b][2] * swv.z * sxv; acc[a][b][3] = (float)iacc[a][b][3] * swv.w * sxv;
        }
      }
    }
    u16* sq = (u16*)smem; u16* sk = (u16*)(smem + 128 * 136 * 2);
    {
      const int pl = (wave >> 1) * 64 + (lane >> 4) * 4, ql = (wave & 1) * 64 + (lane & 15);
#pragma unroll
      for (int a = 0; a < 4; ++a)
#pragma unroll
        for (int b = 0; b < 4; ++b)
          store4bf(sq + (ql + b * 16) * 136 + pl + a * 16, acc[a][b][0], acc[a][b][1], acc[a][b][2], acc[a][b][3]);
      const u16* skg = SK + (size_t)slot * 128 * 128;
#pragma unroll
      for (int i = 0; i < 8; ++i) {
        const int ch = tid + 256 * i, row = ch >> 4, cc = (ch & 15) * 8;
        *(uint4*)(sk + row * 136 + cc) = *(const uint4*)(skg + row * 128 + cc);
      }
    }
    __syncthreads();
    zero_acc(acc);
    {
      const int wp = wave >> 1, wq = wave & 1;
#pragma unroll
      for (int ks = 0; ks < 4; ++ks) {
        bf16x8 fa[4], fb[4];
#pragma unroll
        for (int mt = 0; mt < 4; ++mt) fa[mt] = *(const bf16x8*)(sk + (wp * 64 + mt * 16 + (lane & 15)) * 136 + ks * 32 + (lane >> 4) * 8);
#pragma unroll
        for (int nt = 0; nt < 4; ++nt) fb[nt] = *(const bf16x8*)(sq + (wq * 64 + nt * 16 + (lane & 15)) * 136 + ks * 32 + (lane >> 4) * 8);
#pragma unroll
        for (int mt = 0; mt < 4; ++mt)
#pragma unroll
          for (int nt = 0; nt < 4; ++nt) acc[mt][nt] = mfma16(fa[mt], fb[nt], acc[mt][nt]);
      }
    }
    __syncthreads();
    float* sc = (float*)smem;
    {
      const int kl = (wave >> 1) * 64 + (lane >> 4) * 4, tl = (wave & 1) * 64 + (lane & 15);
#pragma unroll
      for (int a = 0; a < 4; ++a)
#pragma unroll
        for (int b = 0; b < 4; ++b)
#pragma unroll
          for (int i = 0; i < 4; ++i) sc[(tl + b * 16) * 129 + kl + a * 16 + i] = acc[a][b][i];
    }
    __syncthreads();
    const int row = tid & 127, half = tid >> 7;
    float v[16];
#pragma unroll
    for (int i = 0; i < 16; ++i) v[i] = -INFINITY;
#pragma unroll 4
    for (int j = 0; j < 64; ++j) {
      const int key = half * 64 + j;
      const float s = sc[row * 129 + key];
      float x = __uint_as_float((__float_as_uint(s) & ~127u) | (unsigned)(127 - key));
#pragma unroll
      for (int i = 0; i < 16; ++i) { const float hi = fmaxf(v[i], x); x = fminf(v[i], x); v[i] = hi; }
    }
    __syncthreads();
    if (half) {
#pragma unroll
      for (int i = 0; i < 16; ++i) sc[row * 17 + i] = v[i];
    }
    __syncthreads();
    if (!half) {
#pragma unroll
      for (int j = 0; j < 16; ++j) {
        float x = sc[row * 17 + j];
#pragma unroll
        for (int i = 0; i < 16; ++i) { const float hi = fmaxf(v[i], x); x = fminf(v[i], x); v[i] = hi; }
      }
      float* dst = topk + ((size_t)(mt_ * 128 + row) * 16 + slot) * 16;
#pragma unroll
      for (int i = 0; i < 4; ++i) *(float4*)(dst + i * 4) = make_float4(v[4 * i], v[4 * i + 1], v[4 * i + 2], v[4 * i + 3]);
    }
  }
}

__device__ const unsigned char kCandI[64] = {
  0,0,0,0,0,0,0,0,0,0,0,0,0,0,0,0, 1,1,1,1,1,1,1,1, 2,2,2,2,2, 3,3,3,3, 4,4,4, 5,5, 6,6, 7,7, 8,9,10,11,12,13,14,15,
  0,0,0,0,0,0,0,0,0,0,0,0,0,0};
__device__ const unsigned char kCandJ[64] = {
  0,1,2,3,4,5,6,7,8,9,10,11,12,13,14,15, 0,1,2,3,4,5,6,7, 0,1,2,3,4, 0,1,2,3, 0,1,2, 0,1, 0,1, 0,1, 0,0,0,0,0,0,0,0,
  0,0,0,0,0,0,0,0,0,0,0,0,0,0};

DI void phase_peer_gather(const Params& p, int layer, const float* Xin, float* Xout, u16* Xoutb, const float* lng,
                          const float* lnb, char* smem) {
  const int tid = TIDX, lane = tid & 63, wave = tid >> 6;
  char* wsm = smem + wave * 3072;
  float* stk = (float*)wsm; int* sidx = (int*)(wsm + 1024); float* swt = (float*)(wsm + 1536); float* sact = (float*)(wsm + 2048);
  const u8* U = p.Uq + (size_t)layer * 16384 * 1024;
  const u8* V = p.Vq + (size_t)layer * 16384 * 1024;
  const float* scU = p.scU + layer * 16384;
  const float* scV = p.scV + layer * 16384;
  const float* topk = (const float*)p.B6;
  const int ci = kCandI[lane], cj = kCandJ[lane];
  float4 nx0, nx1, nx2, nx3, ntk;
  {
    const int tok0 = BIDX * 4 + wave;
    const float* xr = Xin + (size_t)tok0 * 1024 + lane * 16;
    nx0 = *(const float4*)xr; nx1 = *(const float4*)(xr + 4); nx2 = *(const float4*)(xr + 8); nx3 = *(const float4*)(xr + 12);
    ntk = *(const float4*)(topk + (size_t)tok0 * 256 + lane * 4);
  }
  for (int bi = BIDX; bi < S / 4; bi += gridDim.x) {
    const int tok = bi * 4 + wave;
    const float4 x0 = nx0, x1 = nx1, x2 = nx2, x3 = nx3, tkv = ntk;
    {
      const int bn = (bi + (int)gridDim.x < S / 4) ? bi + (int)gridDim.x : bi;
      const int tokn = bn * 4 + wave;
      const float* xr = Xin + (size_t)tokn * 1024 + lane * 16;
      nx0 = *(const float4*)xr; nx1 = *(const float4*)(xr + 4); nx2 = *(const float4*)(xr + 8); nx3 = *(const float4*)(xr + 12);
      ntk = *(const float4*)(topk + (size_t)tokn * 256 + lane * 4);
    }
    float mxa = fmaxf(fmaxf(absmax4(x0), absmax4(x1)), fmaxf(absmax4(x2), absmax4(x3)));
    mxa = wave_max(mxa);
    const float sx = mxa > 0.f ? mxa * (1.f / 127.f) : 1.f;
    const float sxi = 1.f / sx;
    __builtin_amdgcn_fence(__ATOMIC_ACQ_REL, "wavefront");
    *(float4*)(stk + lane * 4) = tkv;
#pragma unroll 1
    for (int h = 0; h < 8; ++h) {
      const unsigned ua = __float_as_uint(stk[(h * 2) * 16 + ci]);
      const unsigned ub = __float_as_uint(stk[(h * 2 + 1) * 16 + cj]);
      const float val = (lane < 50) ? __uint_as_float(ua & ~127u) + __uint_as_float(ub & ~127u) : -3.0e38f;
      const int eidx = (127 - (int)(ua & 127u)) * 128 + (127 - (int)(ub & 127u));
      const float key = __uint_as_float((__float_as_uint(val) & ~63u) | (unsigned)(63 - lane));
      const int kbits = (int)__float_as_uint(key);
      int cnt = 0;
#pragma unroll 10
      for (int j = 0; j < 50; ++j) {
        const float vj = __uint_as_float((unsigned)__builtin_amdgcn_readlane(kbits, j));
        cnt += (vj > key) ? 1 : 0;
      }
      const float mx = __uint_as_float((unsigned)__builtin_amdgcn_readlane((int)__float_as_uint(val), 0));
      const float e = (cnt < 16) ? __expf(val - mx) : 0.f;
      const float sum = wave_sum(e);
      if (cnt < 16) { sidx[h * 16 + cnt] = eidx; swt[h * 16 + cnt] = e / sum; }
    }
    __builtin_amdgcn_fence(__ATOMIC_ACQ_REL, "wavefront");
    {
      const int xq0 = (int)q8x4(x0, sxi, 0), xq1 = (int)q8x4(x1, sxi, 0), xq2 = (int)q8x4(x2, sxi, 0), xq3 = (int)q8x4(x3, sxi, 0);
      const bool b5 = (lane & 32) != 0, b4 = (lane & 16) != 0, b3 = (lane & 8) != 0;
      const int eslot = (b5 ? 4 : 0) + (b4 ? 2 : 0) + (b3 ? 1 : 0);
#pragma unroll 2
      for (int e0 = 0; e0 < 128; e0 += 8) {
        i32x4 a[8];
#pragma unroll
        for (int j2 = 0; j2 < 8; ++j2) {
          const int ei = __builtin_amdgcn_readfirstlane(sidx[e0 + j2]);
          a[j2] = *(const i32x4*)(U + (size_t)ei * 1024 + lane * 16);
        }
        int pp[8];
#pragma unroll
        for (int j2 = 0; j2 < 8; ++j2) {
          int c = __builtin_amdgcn_sdot4(a[j2][0], xq0, 0, false);
          c = __builtin_amdgcn_sdot4(a[j2][1], xq1, c, false);
          c = __builtin_amdgcn_sdot4(a[j2][2], xq2, c, false);
          pp[j2] = __builtin_amdgcn_sdot4(a[j2][3], xq3, c, false);
        }
        int qq[4];
#pragma unroll
        for (int j2 = 0; j2 < 4; ++j2) {
          const int snd = b5 ? pp[j2] : pp[j2 + 4];
          const int keep = b5 ? pp[j2 + 4] : pp[j2];
          qq[j2] = keep + __shfl_xor(snd, 32);
        }
        int rr[2];
#pragma unroll
        for (int j2 = 0; j2 < 2; ++j2) {
          const int snd = b4 ? qq[j2] : qq[j2 + 2];
          const int keep = b4 ? qq[j2 + 2] : qq[j2];
          rr[j2] = keep + __shfl_xor(snd, 16);
        }
        int ss;
        {
          const int snd = b3 ? rr[0] : rr[1];
          const int keep = b3 ? rr[1] : rr[0];
          ss = keep + __shfl_xor(snd, 8);
        }
        ss += __shfl_xor(ss, 4);
        ss += __shfl_xor(ss, 2);
        ss += __shfl_xor(ss, 1);
        if ((lane & 7) == 0) sact[e0 + eslot] = (float)ss;
      }
    }
    __builtin_amdgcn_fence(__ATOMIC_ACQ_REL, "wavefront");
    float scw;
    {
      float wv[2];
#pragma unroll
      for (int q2 = 0; q2 < 2; ++q2) {
        const int e = lane + 64 * q2;
        const int idx = sidx[e];
        const float a = sact[e] * sx * scU[idx];
        wv[q2] = swt[e] * 0.5f * a * (1.f + erff(a * 0.70710678118654752f)) * scV[idx];
      }
      const float wm = wave_max(fmaxf(fabsf(wv[0]), fabsf(wv[1])));
      scw = wm > 0.f ? wm * (1.f / 127.f) : 1.f;
      const float winv = 1.f / scw;
      u8* sw8 = (u8*)swt;
      __builtin_amdgcn_fence(__ATOMIC_ACQ_REL, "wavefront");
      sw8[lane] = (u8)q8(wv[0], winv, 0);
      sw8[lane + 64] = (u8)q8(wv[1], winv, 0);
    }
    __builtin_amdgcn_fence(__ATOMIC_ACQ_REL, "wavefront");
    int oi[16];
#pragma unroll
    for (int i = 0; i < 16; ++i) oi[i] = 0;
    const unsigned* sw32 = (const unsigned*)swt;
#pragma unroll 1
    for (int e0 = 0; e0 < 128; e0 += 8) {
      u32x4 bb[8];
#pragma unroll
      for (int j = 0; j < 8; ++j) {
        const int ei = __builtin_amdgcn_readfirstlane(sidx[e0 + j]);
        bb[j] = *(const u32x4*)(V + (size_t)ei * 1024 + lane * 16);
      }
#pragma unroll
      for (int g = 0; g < 2; ++g) {
        const int w4 = (int)sw32[(e0 >> 2) + g];
#pragma unroll
        for (int d = 0; d < 4; ++d) {
          const unsigned r0 = bb[4 * g][d], r1 = bb[4 * g + 1][d], r2 = bb[4 * g + 2][d], r3 = bb[4 * g + 3][d];
          const unsigned ta = __builtin_amdgcn_perm(r1, r0, 0x05010400u);
          const unsigned tb = __builtin_amdgcn_perm(r3, r2, 0x05010400u);
          const unsigned tc = __builtin_amdgcn_perm(r1, r0, 0x07030602u);
          const unsigned td = __builtin_amdgcn_perm(r3, r2, 0x07030602u);
          const unsigned c0 = __builtin_amdgcn_perm(tb, ta, 0x05040100u);
          const unsigned c1 = __builtin_amdgcn_perm(tb, ta, 0x07060302u);
          const unsigned c2 = __builtin_amdgcn_perm(td, tc, 0x05040100u);
          const unsigned c3 = __builtin_amdgcn_perm(td, tc, 0x07060302u);
          oi[4 * d + 0] = __builtin_amdgcn_sdot4((int)c0, w4, oi[4 * d + 0], false);
          oi[4 * d + 1] = __builtin_amdgcn_sdot4((int)c1, w4, oi[4 * d + 1], false);
          oi[4 * d + 2] = __builtin_amdgcn_sdot4((int)c2, w4, oi[4 * d + 2], false);
          oi[4 * d + 3] = __builtin_amdgcn_sdot4((int)c3, w4, oi[4 * d + 3], false);
        }
      }
    }
    const float corr = 0.f;
    float o[16];
#pragma unroll
    for (int i = 0; i < 16; ++i) o[i] = (float)oi[i] * scw;
    float y[16];
    y[0] = DN_ALPHA * x0.x + o[0] - corr; y[1] = DN_ALPHA * x0.y + o[1] - corr; y[2] = DN_ALPHA * x0.z + o[2] - corr; y[3] = DN_ALPHA * x0.w + o[3] - corr;
    y[4] = DN_ALPHA * x1.x + o[4] - corr; y[5] = DN_ALPHA * x1.y + o[5] - corr; y[6] = DN_ALPHA * x1.z + o[6] - corr; y[7] = DN_ALPHA * x1.w + o[7] - corr;
    y[8] = DN_ALPHA * x2.x + o[8] - corr; y[9] = DN_ALPHA * x2.y + o[9] - corr; y[10] = DN_ALPHA * x2.z + o[10] - corr; y[11] = DN_ALPHA * x2.w + o[11] - corr;
    y[12] = DN_ALPHA * x3.x + o[12] - corr; y[13] = DN_ALPHA * x3.y + o[13] - corr; y[14] = DN_ALPHA * x3.z + o[14] - corr; y[15] = DN_ALPHA * x3.w + o[15] - corr;
    float s_ = 0.f;
#pragma unroll
    for (int i = 0; i < 16; ++i) s_ += y[i];
    const float mean = wave_sum(s_) * (1.f / 1024.f);
    float q = 0.f;
#pragma unroll
    for (int i = 0; i < 16; ++i) { y[i] -= mean; q += y[i] * y[i]; }
    const float rstd = rsqrtf(wave_sum(q) * (1.f / 1024.f) + NORM_EPS);
    const int col = lane * 16;
    float r_[16];
#pragma unroll
    for (int i = 0; i < 16; ++i) r_[i] = y[i] * rstd * lng[col + i] + lnb[col + i];
    float* xo = Xout + (size_t)tok * 1024 + col;
#pragma unroll
    for (int i = 0; i < 4; ++i) *(float4*)(xo + 4 * i) = make_float4(r_[4 * i], r_[4 * i + 1], r_[4 * i + 2], r_[4 * i + 3]);
    {
      float am = 0.f;
#pragma unroll
      for (int i = 0; i < 16; ++i) am = fmaxf(am, fabsf(r_[i]));
      am = wave_max(am);
      const float sc = am > 0.f ? am * (1.f / 127.f) : 1.f;
      const float inv = 1.f / sc;
      u32x4 o8;
#pragma unroll
      for (int k = 0; k < 4; ++k) o8[k] = q8(r_[4 * k], inv, 0) | (q8(r_[4 * k + 1], inv, 0) << 8) | (q8(r_[4 * k + 2], inv, 0) << 16) | (q8(r_[4 * k + 3], inv, 0) << 24);
      *(u32x4*)(p.Xq8 + (size_t)tok * 1024 + col) = o8;
      if (lane == 0) p.sxq[tok] = sc;
    }
  }
}

DI void phase_peer_u(const Params& p, int layer, const float* Xin, char* smem) {
  const int tid = TIDX, lane = tid & 63, wave = tid >> 6;
  char* wsm = smem + wave * 13312;
  u8* sxq = (u8*)wsm;
  int* sidx = (int*)(wsm + 4096);
  float* sgate = (float*)(wsm + 6144);
  float* sact = (float*)(wsm + 8192);
  unsigned* slist = (unsigned*)(wsm + 10240);
  float* stk = (float*)(wsm + 12288);
  const u8* U = p.Uq + (size_t)layer * 16384 * 1024;
  const float* scU = p.scU + layer * 16384;
  const float* scV = p.scV + layer * 16384;
  float* topk = (float*)p.B6;
  const int ci = kCandI[lane], cj = kCandJ[lane];
  const int ntw = (S / 4) / (int)gridDim.x;
  for (int g0 = 0; g0 < ntw; g0 += 4) {
    float sxr[4];
    unsigned ent[8];
#pragma unroll
    for (int k = 0; k < 4; ++k) {
      const int tok = (BIDX + (g0 + k) * (int)gridDim.x) * 4 + wave;
      const float* xr = Xin + (size_t)tok * 1024 + lane * 16;
      const float4 x0 = *(const float4*)xr, x1 = *(const float4*)(xr + 4), x2 = *(const float4*)(xr + 8), x3 = *(const float4*)(xr + 12);
      const float4 tkv = *(const float4*)(topk + (size_t)tok * 256 + lane * 4);
      float mxa = fmaxf(fmaxf(absmax4(x0), absmax4(x1)), fmaxf(absmax4(x2), absmax4(x3)));
      mxa = wave_max(mxa);
      const float sx = mxa > 0.f ? mxa * (1.f / 127.f) : 1.f;
      const float sxi = 1.f / sx;
      sxr[k] = sx;
      {
        u32x4 o; o[0] = q8x4(x0, sxi, 0); o[1] = q8x4(x1, sxi, 0); o[2] = q8x4(x2, sxi, 0); o[3] = q8x4(x3, sxi, 0);
        *(u32x4*)(sxq + k * 1024 + lane * 16) = o;
      }
      __builtin_amdgcn_fence(__ATOMIC_ACQ_REL, "wavefront");
      *(float4*)(stk + lane * 4) = tkv;
      __builtin_amdgcn_fence(__ATOMIC_ACQ_REL, "wavefront");
#pragma unroll 1
      for (int h = 0; h < 8; ++h) {
        const unsigned ua = __float_as_uint(stk[(h * 2) * 16 + ci]);
        const unsigned ub = __float_as_uint(stk[(h * 2 + 1) * 16 + cj]);
        const float val = (lane < 50) ? __uint_as_float(ua & ~127u) + __uint_as_float(ub & ~127u) : -3.0e38f;
        const int eidx = (127 - (int)(ua & 127u)) * 128 + (127 - (int)(ub & 127u));
        const float key = __uint_as_float((__float_as_uint(val) & ~63u) | (unsigned)(63 - lane));
        const int kbits = (int)__float_as_uint(key);
        int cnt = 0;
#pragma unroll 10
        for (int j = 0; j < 50; ++j) {
          const float vj = __uint_as_float((unsigned)__builtin_amdgcn_readlane(kbits, j));
          cnt += (vj > key) ? 1 : 0;
        }
        const float mx = __uint_as_float((unsigned)__builtin_amdgcn_readlane((int)__float_as_uint(val), 0));
        const float e = (cnt < 16) ? __expf(val - mx) : 0.f;
        const float sum = wave_sum(e);
        if (cnt < 16) { sidx[k * 128 + h * 16 + cnt] = eidx; sgate[k * 128 + h * 16 + cnt] = e / sum; }
      }
      __builtin_amdgcn_fence(__ATOMIC_ACQ_REL, "wavefront");
      ent[2 * k] = (unsigned)sidx[k * 128 + lane] | ((unsigned)k << 14) | ((unsigned)lane << 17);
      ent[2 * k + 1] = (unsigned)sidx[k * 128 + lane + 64] | ((unsigned)k << 14) | ((unsigned)(lane + 64) << 17);
    }
    {
      int base = 0;
#pragma unroll 1
      for (int r = 0; r < 8; ++r) {
#pragma unroll
        for (int q2 = 0; q2 < 8; ++q2) {
          const bool mine = ((int)((ent[q2] & 0x3fffu) >> 11) ^ (((g0 >> 2) & 1) ? 7 : 0)) == r;
          const unsigned long long m = __builtin_amdgcn_ballot_w64(mine);
          if (mine) slist[base + (int)__builtin_amdgcn_mbcnt_hi((unsigned)(m >> 32), __builtin_amdgcn_mbcnt_lo((unsigned)m, 0u))] = ent[q2];
          base += __builtin_popcountll(m);
        }
      }
    }
    __builtin_amdgcn_fence(__ATOMIC_ACQ_REL, "wavefront");
    {
      const bool b5 = (lane & 32) != 0, b4 = (lane & 16) != 0, b3 = (lane & 8) != 0;
      const int eslot = (b5 ? 4 : 0) + (b4 ? 2 : 0) + (b3 ? 1 : 0);
      unsigned evn = slist[lane & 7];
#pragma unroll 2
      for (int c = 0; c < 64; ++c) {
        i32x4 a[8], xq[8];
        int adr[8];
        const int ev = (int)evn;
        evn = slist[((c + 1 < 64) ? c + 1 : c) * 8 + (lane & 7)];
#pragma unroll
        for (int j2 = 0; j2 < 8; ++j2) {
          const unsigned en = (unsigned)__builtin_amdgcn_readlane(ev, j2);
          const int ei = (int)(en & 0x3fffu), kk = (int)((en >> 14) & 7u);
          adr[j2] = kk * 128 + (int)(en >> 17);
          a[j2] = *(const i32x4*)(U + (size_t)ei * 1024 + lane * 16);
          xq[j2] = *(const i32x4*)(sxq + kk * 1024 + lane * 16);
        }
        int pp[8];
#pragma unroll
        for (int j2 = 0; j2 < 8; ++j2) {
          int cc = __builtin_amdgcn_sdot4(a[j2][0], xq[j2][0], 0, false);
          cc = __builtin_amdgcn_sdot4(a[j2][1], xq[j2][1], cc, false);
          cc = __builtin_amdgcn_sdot4(a[j2][2], xq[j2][2], cc, false);
          pp[j2] = __builtin_amdgcn_sdot4(a[j2][3], xq[j2][3], cc, false);
        }
        int qq[4];
#pragma unroll
        for (int j2 = 0; j2 < 4; ++j2) {
          const auto sw = __builtin_amdgcn_permlane32_swap((unsigned)pp[j2], (unsigned)pp[j2 + 4], false, false);
          qq[j2] = (int)sw[0] + (int)sw[1];
        }
        int rr[2];
#pragma unroll
        for (int j2 = 0; j2 < 2; ++j2) {
          const auto sw = __builtin_amdgcn_permlane16_swap((unsigned)qq[j2], (unsigned)qq[j2 + 2], false, false);
          rr[j2] = (int)sw[0] + (int)sw[1];
        }
        int ss;
        {
          const int snd = b3 ? rr[0] : rr[1];
          const int keep = b3 ? rr[1] : rr[0];
          ss = keep + __builtin_amdgcn_update_dpp(0, snd, 0x140, 0xf, 0xf, true);
        }
        ss += __builtin_amdgcn_update_dpp(0, ss, 0xB1, 0xf, 0xf, true);
        ss += __builtin_amdgcn_update_dpp(0, ss, 0x4E, 0xf, 0xf, true);
        ss += __builtin_amdgcn_update_dpp(0, ss, 0x141, 0xf, 0xf, true);
        int ad = adr[0];
#pragma unroll
        for (int j2 = 1; j2 < 8; ++j2) ad = (eslot == j2) ? adr[j2] : ad;
        if ((lane & 7) == 0) sact[ad] = (float)ss;
      }
    }
    __builtin_amdgcn_fence(__ATOMIC_ACQ_REL, "wavefront");
#pragma unroll
    for (int k = 0; k < 4; ++k) {
      const int tok = (BIDX + (g0 + k) * (int)gridDim.x) * 4 + wave;
      int* gl = (int*)(topk + (size_t)tok * 256);
#pragma unroll
      for (int q2 = 0; q2 < 2; ++q2) {
        const int e = lane + 64 * q2;
        const int idx = sidx[k * 128 + e];
        const float a = sact[k * 128 + e] * sxr[k] * scU[idx];
        gl[e] = idx;
        ((float*)gl)[128 + e] = sgate[k * 128 + e] * 0.5f * a * (1.f + erff(a * 0.70710678118654752f)) * scV[idx];
      }
    }
    __builtin_amdgcn_fence(__ATOMIC_ACQ_REL, "wavefront");
  }
}

DI void phase_peer_v(const Params& p, int layer, const float* Xin, float* Xout, const float* lng, const float* lnb, char* smem) {
  const int tid = TIDX, lane = tid & 63, wave = tid >> 6;
  char* wsm = smem + wave * 2048;
  int* sidx = (int*)wsm; float* swt = (float*)(wsm + 512); int* sraw = (int*)(wsm + 1024);
  const u8* V = p.Vq + (size_t)layer * 16384 * 1024;
  const float* lists = (const float*)p.B6;
  float4 nx0, nx1, nx2, nx3, nlv;
  {
    const int tok0 = BIDX * 4 + wave;
    const float* xr = Xin + (size_t)tok0 * 1024 + lane * 16;
    nx0 = *(const float4*)xr; nx1 = *(const float4*)(xr + 4); nx2 = *(const float4*)(xr + 8); nx3 = *(const float4*)(xr + 12);
    nlv = *(const float4*)(lists + (size_t)tok0 * 256 + lane * 4);
  }
  for (int bi = BIDX; bi < S / 4; bi += gridDim.x) {
    const int tok = bi * 4 + wave;
    const float4 x0 = nx0, x1 = nx1, x2 = nx2, x3 = nx3, lv = nlv;
    {
      const int bn = (bi + (int)gridDim.x < S / 4) ? bi + (int)gridDim.x : bi;
      const int tokn = bn * 4 + wave;
      const float* xr = Xin + (size_t)tokn * 1024 + lane * 16;
      nx0 = *(const float4*)xr; nx1 = *(const float4*)(xr + 4); nx2 = *(const float4*)(xr + 8); nx3 = *(const float4*)(xr + 12);
      nlv = *(const float4*)(lists + (size_t)tokn * 256 + lane * 4);
    }
    __builtin_amdgcn_fence(__ATOMIC_ACQ_REL, "wavefront");
    *(float4*)((float*)sraw + lane * 4) = lv;
    __builtin_amdgcn_fence(__ATOMIC_ACQ_REL, "wavefront");
    float scw;
    {
      const int i0 = sraw[lane], i1 = sraw[lane + 64];
      const float w0 = __int_as_float(sraw[128 + lane]), w1 = __int_as_float(sraw[128 + lane + 64]);
      const float wm = wave_max(fmaxf(fabsf(w0), fabsf(w1)));
      scw = wm > 0.f ? wm * (1.f / 127.f) : 1.f;
      const float winv = 1.f / scw;
      const unsigned q0 = q8(w0, winv, 0), q1 = q8(w1, winv, 0);
      u8* sw8 = (u8*)swt;
      const int flip = (((bi - BIDX) / (int)gridDim.x) & 1) ? 7 : 0;
      const int r0 = (i0 >> 11) ^ flip, r1 = (i1 >> 11) ^ flip;
      int base = 0;
#pragma unroll 1
      for (int r = 0; r < 8; ++r) {
        const unsigned long long m0 = __builtin_amdgcn_ballot_w64(r0 == r);
        const unsigned long long m1 = __builtin_amdgcn_ballot_w64(r1 == r);
        const int c0 = __builtin_popcountll(m0);
        if (r0 == r) {
          const int pos = base + (int)__builtin_amdgcn_mbcnt_hi((unsigned)(m0 >> 32), __builtin_amdgcn_mbcnt_lo((unsigned)m0, 0u));
          sidx[pos] = i0; sw8[pos] = (u8)q0;
        }
        if (r1 == r) {
          const int pos = base + c0 + (int)__builtin_amdgcn_mbcnt_hi((unsigned)(m1 >> 32), __builtin_amdgcn_mbcnt_lo((unsigned)m1, 0u));
          sidx[pos] = i1; sw8[pos] = (u8)q1;
        }
        base += c0 + __builtin_popcountll(m1);
      }
    }
    __builtin_amdgcn_fence(__ATOMIC_ACQ_REL, "wavefront");
    int oi[16];
#pragma unroll
    for (int i = 0; i < 16; ++i) oi[i] = 0;
    const unsigned* sw32 = (const unsigned*)swt;
    int ivn = sidx[lane & 7];
#pragma unroll 1
    for (int e0 = 0; e0 < 128; e0 += 8) {
      u32x4 bb[8];
      const int iv = ivn;
      ivn = sidx[((e0 + 8 < 128) ? e0 + 8 : e0) + (lane & 7)];
#pragma unroll
      for (int j = 0; j < 8; ++j) {
        const int ei = __builtin_amdgcn_readlane(iv, j);
        bb[j] = *(const u32x4*)(V + (size_t)ei * 1024 + lane * 16);
      }
#pragma unroll
      for (int g = 0; g < 2; ++g) {
        const int w4 = (int)sw32[(e0 >> 2) + g];
#pragma unroll
        for (int d = 0; d < 4; ++d) {
          const unsigned r0 = bb[4 * g][d], r1 = bb[4 * g + 1][d], r2 = bb[4 * g + 2][d], r3 = bb[4 * g + 3][d];
          const unsigned ta = __builtin_amdgcn_perm(r1, r0, 0x05010400u);
          const unsigned tb = __builtin_amdgcn_perm(r3, r2, 0x05010400u);
          const unsigned tc = __builtin_amdgcn_perm(r1, r0, 0x07030602u);
          const unsigned td = __builtin_amdgcn_perm(r3, r2, 0x07030602u);
          const unsigned c0 = __builtin_amdgcn_perm(tb, ta, 0x05040100u);
          const unsigned c1 = __builtin_amdgcn_perm(tb, ta, 0x07060302u);
          const unsigned c2 = __builtin_amdgcn_perm(td, tc, 0x05040100u);
          const unsigned c3 = __builtin_amdgcn_perm(td, tc, 0x07060302u);
          oi[4 * d + 0] = __builtin_amdgcn_sdot4((int)c0, w4, oi[4 * d + 0], false);
          oi[4 * d + 1] = __builtin_amdgcn_sdot4((int)c1, w4, oi[4 * d + 1], false);
          oi[4 * d + 2] = __builtin_amdgcn_sdot4((int)c2, w4, oi[4 * d + 2], false);
          oi[4 * d + 3] = __builtin_amdgcn_sdot4((int)c3, w4, oi[4 * d + 3], false);
        }
      }
    }
    const float corr = 0.f;
    float o[16];
#pragma unroll
    for (int i = 0; i < 16; ++i) o[i] = (float)oi[i] * scw;
    float y[16];
    y[0] = DN_ALPHA * x0.x + o[0] - corr; y[1] = DN_ALPHA * x0.y + o[1] - corr; y[2] = DN_ALPHA * x0.z + o[2] - corr; y[3] = DN_ALPHA * x0.w + o[3] - corr;
    y[4] = DN_ALPHA * x1.x + o[4] - corr; y[5] = DN_ALPHA * x1.y + o[5] - corr; y[6] = DN_ALPHA * x1.z + o[6] - corr; y[7] = DN_ALPHA * x1.w + o[7] - corr;
    y[8] = DN_ALPHA * x2.x + o[8] - corr; y[9] = DN_ALPHA * x2.y + o[9] - corr; y[10] = DN_ALPHA * x2.z + o[10] - corr; y[11] = DN_ALPHA * x2.w + o[11] - corr;
    y[12] = DN_ALPHA * x3.x + o[12] - corr; y[13] = DN_ALPHA * x3.y + o[13] - corr; y[14] = DN_ALPHA * x3.z + o[14] - corr; y[15] = DN_ALPHA * x3.w + o[15] - corr;
    float s_ = 0.f;
#pragma unroll
    for (int i = 0; i < 16; ++i) s_ += y[i];
    const float mean = wave_sum(s_) * (1.f / 1024.f);
    float q = 0.f;
#pragma unroll
    for (int i = 0; i < 16; ++i) { y[i] -= mean; q += y[i] * y[i]; }
    const float rstd = rsqrtf(wave_sum(q) * (1.f / 1024.f) + NORM_EPS);
    const int col = lane * 16;
    float r_[16];
#pragma unroll
    for (int i = 0; i < 16; ++i) r_[i] = y[i] * rstd * lng[col + i] + lnb[col + i];
    float* xo = Xout + (size_t)tok * 1024 + col;
#pragma unroll
    for (int i = 0; i < 4; ++i) *(float4*)(xo + 4 * i) = make_float4(r_[4 * i], r_[4 * i + 1], r_[4 * i + 2], r_[4 * i + 3]);
    {
      float am = 0.f;
#pragma unroll
      for (int i = 0; i < 16; ++i) am = fmaxf(am, fabsf(r_[i]));
      am = wave_max(am);
      const float sc = am > 0.f ? am * (1.f / 127.f) : 1.f;
      const float inv = 1.f / sc;
      u32x4 o8;
#pragma unroll
      for (int k = 0; k < 4; ++k) o8[k] = q8(r_[4 * k], inv, 0) | (q8(r_[4 * k + 1], inv, 0) << 8) | (q8(r_[4 * k + 2], inv, 0) << 16) | (q8(r_[4 * k + 3], inv, 0) << 24);
      *(u32x4*)(p.Xq8 + (size_t)tok * 1024 + col) = o8;
      if (lane == 0) p.sxq[tok] = sc;
    }
  }
}

DI void phase_ple(const Params& p, int layer, const float* X, const u16* Xb, float* Xout, u16* Xoutb, char* smem) {
  const u8* Wg8 = p.Wg8 + (size_t)layer * 1024 * 1024;
  const float* swl = p.swg + layer * 1024;
  const u16* pe = p.B2;
  TILE_LOOP(8) {
    const int p0 = nt_ * 128, q0 = mt_ * 128;
    f32x4 acc[4][4];
    {
      i32x4_t iacc[4][4];
#pragma unroll
      for (int a = 0; a < 4; ++a)
#pragma unroll
        for (int b = 0; b < 4; ++b) iacc[a][b] = i32x4_t{0, 0, 0, 0};
      gemm_core_i8(Wg8, 1024, p.Xq8, 1024, 1024, p0, q0, smem, iacc);
      const int lane = TIDX & 63, wave = TIDX >> 6;
      const int nb_ = p0 + (wave >> 1) * 64 + (lane >> 4) * 4, mb_ = q0 + (wave & 1) * 64 + (lane & 15);
#pragma unroll
      for (int a = 0; a < 4; ++a) {
        const float4 swv = *(const float4*)(swl + nb_ + a * 16);
#pragma unroll
        for (int b = 0; b < 4; ++b) {
          const float sxv = p.sxq[mb_ + b * 16];
          acc[a][b][0] = (float)iacc[a][b][0] * swv.x * sxv; acc[a][b][1] = (float)iacc[a][b][1] * swv.y * sxv;
          acc[a][b][2] = (float)iacc[a][b][2] * swv.z * sxv; acc[a][b][3] = (float)iacc[a][b][3] * swv.w * sxv;
        }
      }
    }
    EPI_BEGIN
      const size_t o_ = (size_t)qb_ * 1024 + pb_;
      const float4 xv = *(const float4*)(X + o_);
      const uint2 pv = *(const uint2*)(pe + o_);
      float4 o;
      o.x = xv.x + sigmoidf_(ev_[0]) * bflo(pv.x); o.y = xv.y + sigmoidf_(ev_[1]) * bfhi(pv.x);
      o.z = xv.z + sigmoidf_(ev_[2]) * bflo(pv.y); o.w = xv.w + sigmoidf_(ev_[3]) * bfhi(pv.y);
      *(float4*)(Xout + o_) = o;
      if (Xoutb) store4bf(Xoutb + o_, o.x, o.y, o.z, o.w);
    EPI_END
  }
}

DI void phase_mla_down(const Params& p, const u16* Xb, float* ckr, char* smem) {
  TILE_LOOP(6) {
    const int p0 = nt_ * 128, q0 = mt_ * 128;
    f32x4 acc[4][4]; zero_acc(acc);
    gemm_core(p.WdT, 1024, Xb, 1024, 1024, p0, q0, smem, acc);
    EPI_BEGIN
      *(f32x4*)(ckr + (size_t)qb_ * 768 + pb_) = ev_;
    EPI_END
  }
}
DI void phase_mla_norm(const Params& p, const float* ckr) {
  const int lane = TIDX & 63, wave = TIDX >> 6;
  for (int row = BIDX * 4 + wave; row < S; row += gridDim.x * 4) {
    const float* cr = ckr + (size_t)row * 768;
    const float4 a = *(const float4*)(cr + lane * 4);
    const float2 b0 = *(const float2*)(cr + 256 + lane * 6), b1 = *(const float2*)(cr + 256 + lane * 6 + 2), b2 = *(const float2*)(cr + 256 + lane * 6 + 4);
    const float kr = cr[640 + lane];
    const float ra = rsqrtf(wave_sum(a.x * a.x + a.y * a.y + a.z * a.z + a.w * a.w) * (1.f / 256.f) + NORM_EPS);
    const float rb = rsqrtf(wave_sum(b0.x * b0.x + b0.y * b0.y + b1.x * b1.x + b1.y * b1.y + b2.x * b2.x + b2.y * b2.y) * (1.f / 384.f) + NORM_EPS);
    store4bf(p.ckvb + (size_t)row * 256 + lane * 4, a.x * ra, a.y * ra, a.z * ra, a.w * ra);
    unsigned* cq = (unsigned*)(p.cqb + (size_t)row * 384 + lane * 6);
    cq[0] = pack2(b0.x * rb, b0.y * rb); cq[1] = pack2(b1.x * rb, b1.y * rb); cq[2] = pack2(b2.x * rb, b2.y * rb);
    const float other = __shfl_xor(kr, 32);
    const int f = lane & 31;
    const float cs = p.ropec[row * 32 + f], sn = p.ropes[row * 32 + f];
    const float o = (lane < 32) ? (kr * cs - other * sn) : (other * sn + kr * cs);
    p.krope[(size_t)row * 64 + lane] = f2bf(o);
  }
}

DI void phase_mla_up(const Params& p, char* smem) {
  u16* knope = p.B2; u16* vTa = p.B3; u16* qatt = p.B0;
  TILE_LOOP(28) {
    f32x4 acc[4][4]; zero_acc(acc);
    if (nt_ < 16) {
      const int hd = nt_ >> 1;
      if (nt_ & 1) {
        const int p0 = mt_ * 128, q0 = nt_ * 128;
        gemm_core(p.ckvb, 256, p.WupT, 256, 256, p0, q0, smem, acc);
        EPI_BEGIN
          store4bf(vTa + (size_t)(hd * 128 + qb_ - q0) * S + pb_, ev_[0], ev_[1], ev_[2], ev_[3]);
        EPI_END
      } else {
        const int p0 = nt_ * 128, q0 = mt_ * 128;
        gemm_core(p.WupT, 256, p.ckvb, 256, 256, p0, q0, smem, acc);
        EPI_BEGIN
          store4bf(knope + (size_t)qb_ * 1024 + hd * 128 + pb_ - p0, ev_[0], ev_[1], ev_[2], ev_[3]);
        EPI_END
      }
    } else {
      const int p0 = (nt_ - 16) * 128, q0 = mt_ * 128;
      gemm_core(p.WuqT, 384, p.cqb, 384, 384, p0, q0, smem, acc);
      EPI_BEGIN
        const int grp = pb_ >> 6;
        const int w_ = pb_ & 63;
        if ((grp % 3) == 2) {
          if (w_ < 32) {
            const f32x4 x2 = *(const f32x4*)((const float*)smem + er_ * 132 + ec_ + 32);
            const float4 cs = *(const float4*)(p.ropec + (size_t)qb_ * 32 + w_), sn = *(const float4*)(p.ropes + (size_t)qb_ * 32 + w_);
            store4bf(qatt + (size_t)qb_ * 1536 + pb_, ev_[0] * cs.x - x2[0] * sn.x, ev_[1] * cs.y - x2[1] * sn.y,
                     ev_[2] * cs.z - x2[2] * sn.z, ev_[3] * cs.w - x2[3] * sn.w);
            store4bf(qatt + (size_t)qb_ * 1536 + pb_ + 32, ev_[0] * sn.x + x2[0] * cs.x, ev_[1] * sn.y + x2[1] * cs.y,
                     ev_[2] * sn.z + x2[2] * cs.z, ev_[3] * sn.w + x2[3] * cs.w);
          }
        } else {
          store4bf(qatt + (size_t)qb_ * 1536 + pb_, ev_[0], ev_[1], ev_[2], ev_[3]);
        }
      EPI_END
    }
  }
}

DI void phase_attn(const Params& p, char* smem) {
  const u16* knope = p.B2; const u16* vTa = p.B3; const u16* qatt = p.B0; u16* oatt = p.B4;
  u16* sK = (u16*)smem;
  u16* sV = (u16*)(smem + 64 * 400);
  const int tid = TIDX, lane = tid & 63, wave = tid >> 6;
  const int r = lane & 31, hh = lane >> 5;
  for (int pi = BIDX; pi < 512; pi += gridDim.x) {
    const int h = pi & 7, jj = pi >> 3;
    for (int half = 0; half < 2; ++half) {
      const int qb = half ? jj : 127 - jj;
      const int q0 = qb * 128 + wave * 32;
      const int qpos = q0 + r;
      bf16x8 qf[12];
      {
        const u16* qp = qatt + (size_t)qpos * 1536 + h * 192 + hh * 8;
#pragma unroll
        for (int ks = 0; ks < 12; ++ks) qf[ks] = *(const bf16x8*)(qp + ks * 16);
      }
      f32x16 O[4];
#pragma unroll
      for (int mt = 0; mt < 4; ++mt)
#pragma unroll
        for (int i = 0; i < 16; ++i) O[mt][i] = 0.f;
      float m = -INFINITY, l = 0.f;
      const int ntiles = (qb + 1) * 2;
      const u16* knb = knope + h * 128;
      const u16* vtb = vTa + (size_t)h * 128 * S;
      const int offn = (tid >> 4) * 1024 + (tid & 15) * 8;
      const int offr = (tid >> 3) * 64 + (tid & 7) * 8;
      const int offv = (tid >> 3) * S + (tid & 7) * 8;
      u16* dKn = sK + (tid >> 4) * 200 + (tid & 15) * 8;
      u16* dKr = sK + (tid >> 3) * 200 + 128 + (tid & 7) * 8;
      u16* dV = sV + (tid >> 3) * 68 + (tid & 7) * 8;
      for (int t = 0; t < ntiles; ++t) {
        __syncthreads();
        {
          const int k0 = t * 64;
          u32x4 rk[6], rv[4];
#pragma unroll
          for (int i = 0; i < 4; ++i) rk[i] = *(const u32x4*)((knb + (size_t)(k0 + 16 * i) * 1024) + offn);
#pragma unroll
          for (int i = 0; i < 2; ++i) rk[4 + i] = *(const u32x4*)((p.krope + (size_t)(k0 + 32 * i) * 64) + offr);
#pragma unroll
          for (int i = 0; i < 4; ++i) rv[i] = *(const u32x4*)((vtb + (size_t)(32 * i) * S + k0) + offv);
#pragma unroll
          for (int i = 0; i < 4; ++i) *(u32x4*)(dKn + i * 16 * 200) = rk[i];
#pragma unroll
          for (int i = 0; i < 2; ++i) *(u32x4*)(dKr + i * 32 * 200) = rk[4 + i];
#pragma unroll
          for (int i = 0; i < 4; ++i) {
            u32x2* d = (u32x2*)(dV + i * 32 * 68);
            d[0] = u32x2{rv[i][0], rv[i][1]}; d[1] = u32x2{rv[i][2], rv[i][3]};
          }
        }
        __syncthreads();
        const int k0 = t * 64;
        const bool active = (k0 <= q0 + 31);
        f32x16 X[2];
        if (active) {
#pragma unroll
          for (int st = 0; st < 2; ++st) {
#pragma unroll
            for (int i = 0; i < 16; ++i) X[st][i] = 0.f;
#pragma unroll
            for (int ks = 0; ks < 12; ++ks) {
              X[st] = mfma32(*(const bf16x8*)(sK + (st * 32 + r) * 200 + ks * 16 + hh * 8), qf[ks], X[st]);
            }
          }
        }
        if (active) {
          if (k0 + 63 > q0) {
#pragma unroll
            for (int st = 0; st < 2; ++st)
#pragma unroll
              for (int i = 0; i < 16; ++i) {
                const int key = k0 + st * 32 + crow(i, hh);
                if (key > qpos) X[st][i] = -INFINITY;
              }
          }
          float mx = -INFINITY;
#pragma unroll
          for (int st = 0; st < 2; ++st)
#pragma unroll
            for (int i = 0; i < 16; ++i) mx = fmaxf(mx, X[st][i]);
          { const auto sw = __builtin_amdgcn_permlane32_swap(__float_as_uint(mx), __float_as_uint(mx), false, false); mx = fmaxf(__uint_as_float(sw[0]), __uint_as_float(sw[1])); }
          const float mn = fmaxf(m, mx);
          const float alpha = __builtin_amdgcn_exp2f(m - mn);
          m = mn;
          float ps = 0.f;
#pragma unroll
          for (int st = 0; st < 2; ++st)
#pragma unroll
            for (int i = 0; i < 16; ++i) { X[st][i] = __builtin_amdgcn_exp2f(X[st][i] - mn); ps += X[st][i]; }
          l = l * alpha + ps;
          if (__builtin_amdgcn_ballot_w64(alpha != 1.f) != 0ull) {
#pragma unroll
            for (int mt = 0; mt < 4; ++mt)
#pragma unroll
              for (int i = 0; i < 16; ++i) O[mt][i] *= alpha;
          }
#pragma unroll
          for (int st = 0; st < 2; ++st)
#pragma unroll
            for (int k2 = 0; k2 < 2; ++k2) {
              const bf16x8 pf = pack8(X[st][8 * k2 + 0], X[st][8 * k2 + 1], X[st][8 * k2 + 2], X[st][8 * k2 + 3],
                                      X[st][8 * k2 + 4], X[st][8 * k2 + 5], X[st][8 * k2 + 6], X[st][8 * k2 + 7]);
#pragma unroll
              for (int mt = 0; mt < 4; ++mt) {
                const u16* vp = sV + (mt * 32 + r) * 68 + st * 32 + k2 * 16 + hh * 4;
                const s16x4 lo = *(const s16x4*)vp, hi = *(const s16x4*)(vp + 8);
                O[mt] = mfma32(__builtin_shufflevector(lo, hi, 0, 1, 2, 3, 4, 5, 6, 7), pf, O[mt]);
              }
            }
        }
      }
      l += __shfl_xor(l, 32);
      const float inv = 1.f / l;
#pragma unroll
      for (int mt = 0; mt < 4; ++mt)
#pragma unroll
        for (int g4 = 0; g4 < 4; ++g4) {
          const int dv = mt * 32 + 8 * g4 + 4 * hh;
          store4bf(oatt + (size_t)qpos * 1024 + h * 128 + dv, O[mt][4 * g4] * inv, O[mt][4 * g4 + 1] * inv,
                   O[mt][4 * g4 + 2] * inv, O[mt][4 * g4 + 3] * inv);
        }
    }
  }
}

DI void run_phase(int ph, const Params& p, char* smem) {
  switch (ph) {
    case 0: phase_prologue(p, smem); break;
    case 1: phase_inproj(p, smem); break;
    case 2: phase_ml_local(p, smem); break;
    case 3: phase_ml_scan(p); break;
    case 4: phase_ml_out(p, smem); break;
    case 5: phase_outproj(p, 0, p.B0, p.WoaT, p.x, p.F1, smem); break;
    case 6: phase_ln(p.F1, p.B0, p.ln_g, p.ln_b, p.Xq8, p.sxq); break;
    case 7: phase_peer_query(p, 0, p.B0, smem); break;
    case 8: phase_peer_u(p, 0, p.F1, smem); break;
    case 20: phase_peer_v(p, 0, p.F1, p.F2, p.ln_g + 1024, p.ln_b + 1024, smem); break;
    case 9: phase_ple(p, 0, p.F2, p.B1, p.F2, p.B0, smem); break;
    case 10: phase_mla_down(p, p.B0, p.F1, smem); break;
    case 11: phase_mla_norm(p, p.F1); break;
    case 12: phase_mla_up(p, smem); break;
    case 13: phase_attn(p, smem); break;
    case 14: phase_outproj(p, 1, p.B4, p.WobT, p.F2, p.F2, smem); break;
    case 15: phase_ln(p.F2, p.B1, p.ln_g + 2048, p.ln_b + 2048, p.Xq8, p.sxq); break;
    case 16: phase_peer_query(p, 1, p.B1, smem); break;
    case 17: phase_peer_u(p, 1, p.F2, smem); break;
    case 21: phase_peer_v(p, 1, p.F2, p.F1, p.ln_g + 3072, p.ln_b + 3072, smem); break;
    case 18: phase_ple(p, 1, p.F1, p.B0, p.out, nullptr, smem); break;
    default: break;
  }
}


#define XB_TMO      128
#define XB_XCNT(j)  (256  + 64 * (j))
#define XB_XSUB(j)  (1280 + 64 * (j))
#define XB_XGEN(j)  (2304 + 64 * (j))
#define XB_TOP      3328
#define XB_TOPGEN   3392
#define XCD_BAR_WORDS 3456
#define XB_SPIN_CAP (1u << 22)
#define LAS __attribute__((address_space(3)))
DI unsigned xb_ld(unsigned* p) { return __hip_atomic_load(p, __ATOMIC_RELAXED, __HIP_MEMORY_SCOPE_AGENT); }
DI unsigned xb_add(unsigned* p, unsigned v) { return __hip_atomic_fetch_add(p, v, __ATOMIC_RELAXED, __HIP_MEMORY_SCOPE_AGENT); }
DI unsigned xb_xcc_id() { return (unsigned)__builtin_amdgcn_s_getreg((3 << 11) | 20) & 0xFu; }
#define XB_SPIN(cond, bar) do { unsigned _sp = 0; while (cond) { __builtin_amdgcn_s_sleep(1); \
    if ((++_sp & 255u) == 0u) { if (xb_ld(&(bar)[XB_TMO])) break; if (_sp > XB_SPIN_CAP) { atomicAdd(&(bar)[XB_TMO], 1u); break; } } } } while (0)
struct XcdBarrier { unsigned* bar; unsigned x; volatile LAS unsigned* st; };
DI XcdBarrier xcd_barrier_post(unsigned* bar, volatile LAS unsigned* st) {
  XcdBarrier b; b.bar = bar; b.x = xb_xcc_id(); b.st = st;
  if (TIDX == 0) (void)xb_add(&bar[XB_XCNT(b.x)], 1u);
  return b;
}
DI void xcd_barrier_complete(unsigned* bar, unsigned x, unsigned& nloc, unsigned& nx) {
  const unsigned G = gridDim.x * gridDim.y * gridDim.z;
  unsigned sum, cnt, mine, sp = 0u;
  for (;;) {
    sum = 0u; cnt = 0u; mine = 0u;
#pragma unroll
    for (unsigned j = 0; j < 16; ++j) { const unsigned c = xb_ld(&bar[XB_XCNT(j)]); sum += c; cnt += (c > 0u) ? 1u : 0u; mine = (j == x) ? c : mine; }
    if (sum == G) break;
    __builtin_amdgcn_s_sleep(1);
    if ((++sp & 255u) == 0u) { if (xb_ld(&bar[XB_TMO])) break; if (sp > XB_SPIN_CAP) { atomicAdd(&bar[XB_TMO], 1u); break; } }
  }
  nloc = mine > 0u ? mine : 1u; nx = cnt > 0u ? cnt : 1u;
}
DI void xcd_barrier(const XcdBarrier& b) {
  asm volatile("s_waitcnt vmcnt(0)" ::: "memory");
  __syncthreads();
  if (TIDX == 0) {
    unsigned* bar = b.bar;
    __builtin_amdgcn_s_waitcnt(0);
    unsigned nloc = b.st[0], nx = b.st[1];
    if (nloc == 0u) { xcd_barrier_complete(bar, b.x, nloc, nx); b.st[0] = nloc; b.st[1] = nx; }
    const unsigned old = xb_add(&bar[XB_XSUB(b.x)], 1u);
    const unsigned gen = old / nloc;
    if (old + 1u == (gen + 1u) * nloc) {
      __builtin_amdgcn_fence(__ATOMIC_RELEASE, "agent");
      asm volatile("s_waitcnt vmcnt(0)" ::: "memory");
      const unsigned og = xb_add(&bar[XB_TOP], 1u);
      const unsigned tg = og / nx;
      if (og + 1u == (tg + 1u) * nx) xb_add(&bar[XB_TOPGEN], 1u);
      else XB_SPIN(xb_ld(&bar[XB_TOPGEN]) == tg, bar);
      __builtin_amdgcn_fence(__ATOMIC_ACQUIRE, "agent");
      xb_add(&bar[XB_XGEN(b.x)], 1u);
      asm volatile("s_waitcnt vmcnt(0)" ::: "memory");
    } else {
      XB_SPIN(xb_ld(&bar[XB_XGEN(b.x)]) == gen, bar);
      __builtin_amdgcn_fence(__ATOMIC_ACQUIRE, "agent");
      asm volatile("s_waitcnt vmcnt(0)" ::: "memory");
    }
  }
  __syncthreads();
}

#ifndef DUP_MASK
#define DUP_MASK 0u
#endif
#define RUNP(k) { run_phase(k, p, smem); xcd_barrier(xb); if ((DUP_MASK >> (k)) & 1u) { run_phase(k, p, smem); xcd_barrier(xb); } }
#if MEGA
__global__ void __launch_bounds__(256, 2) mega_kernel(Params p) {
  __shared__ __attribute__((aligned(16))) char smem[SMEM_BYTES];
  __shared__ uint4 xb_words;
  cg::grid_group grid = cg::this_grid();
  if (TIDX == 0) xb_words = make_uint4(0u, 0u, 0u, 0u);
  __syncthreads();
  XcdBarrier xb = xcd_barrier_post(p.bar, (volatile LAS unsigned*)&xb_words);
  if (p.out == nullptr) grid.sync();
  RUNP(0) RUNP(1)
  RUNP(2) RUNP(3) RUNP(4) RUNP(5) RUNP(6) RUNP(7) RUNP(8) RUNP(20) RUNP(9)
  RUNP(10) RUNP(11) RUNP(12) RUNP(13) RUNP(14) RUNP(15) RUNP(16) RUNP(17) RUNP(21)
  run_phase(18, p, smem);
}
#else
__global__ void __launch_bounds__(256, 2) phase_kernel(Params p, int ph) {
  __shared__ __attribute__((aligned(16))) char smem[SMEM_BYTES];
  run_phase(ph, p, smem);
}
#endif

extern "C" void kernel_launch(void* const* d_in, const int* in_sizes, int n_in, void* d_out, int out_size, void* d_ws,
                              size_t ws_size, hipStream_t stream) {
  Params p{};
  p.x = (const float*)d_in[0]; p.p = (const float*)d_in[1]; p.pos = (const int*)d_in[2];
  p.ln_g = (const float*)d_in[3]; p.ln_b = (const float*)d_in[4]; p.a_w_in = (const float*)d_in[5];
  p.a_b_if = (const float*)d_in[6]; p.a_hn_g = (const float*)d_in[7]; p.a_w_out = (const float*)d_in[8];
  p.kv_w_down = (const float*)d_in[9]; p.kv_norm_g = (const float*)d_in[10]; p.kv_w_up = (const float*)d_in[11];
  p.b_w_dq = (const float*)d_in[12]; p.b_q_norm_g = (const float*)d_in[13]; p.b_w_uq = (const float*)d_in[14];
  p.b_w_out = (const float*)d_in[15]; p.peer_w_q = (const float*)d_in[16]; p.peer_sub_keys = (const float*)d_in[17];
  p.peer_u = (const float*)d_in[18]; p.peer_v = (const float*)d_in[19]; p.ple_w_proj = (const float*)d_in[20];
  p.ple_w_gate = (const float*)d_in[21];
  p.out = (float*)d_out;
  char* w = (char*)d_ws;
  size_t off = 0;
  auto take = [&](size_t bytes) { char* r = w + off; off += (bytes + 255) & ~(size_t)255; return r; };
  const size_t MB = 1024 * 1024;
  p.WinT = (u16*)take((size_t)3200 * 1024 * 2);
  p.WoaT = (u16*)take(2 * MB);
  p.WpqT = (u16*)take(8 * MB);
  p.SubK = (u16*)take(1 * MB);
  p.WgT = (u16*)take(4 * MB);
  p.WpT = (u16*)take(1 * MB);
  p.WdT = (u16*)take((size_t)768 * 1024 * 2);
  p.WupT = (u16*)take(1 * MB);
  p.WuqT = (u16*)take((size_t)1536 * 384 * 2);
  p.WobT = (u16*)take(2 * MB);
  p.Uq = (u8*)take(32 * MB);
  p.Vq = (u8*)take(32 * MB);
  p.scU = (float*)take(2 * 16384 * 4);
  p.scV = (float*)take(2 * 16384 * 4);
  p.Xq8 = (u8*)take((size_t)S * 1024);
  p.Wq8 = (u8*)take((size_t)2 * 2048 * 1024);
  p.sxq = (float*)take((size_t)S * 4);
  p.swq = (float*)take(2 * 2048 * 4);
  p.Wg8 = (u8*)take((size_t)2 * 1024 * 1024);
  p.swg = (float*)take(2 * 1024 * 4);
  p.Win8 = (u8*)take((size_t)3200 * 1024);
  p.swin = (float*)take(3200 * 4);
  p.pb = (u16*)take(16 * MB);
  p.F1 = (float*)take(64 * MB);
  p.F2 = (float*)take(64 * MB);
  p.B0 = (u16*)take(32 * MB);
  p.B1 = (u16*)take(32 * MB);
  p.B2 = (u16*)take(32 * MB);
  p.B3 = (u16*)take(32 * MB);
  p.B4 = (u16*)take(32 * MB);
  p.B6 = (u16*)take(16 * MB);
  p.igf = (float*)take((size_t)S * 8 * 4);
  p.lf = (float*)take((size_t)S * 8 * 4);
  p.dn = (float*)take((size_t)2048 * 64 * 4);
  p.nprev = (float*)take((size_t)2048 * 64 * 4);
  p.blast = (float*)take(2048 * 4);
  p.mloc = (float*)take(2048 * 4);
  p.mprev = (float*)take(2048 * 4);
  p.ropec = (float*)take((size_t)S * 32 * 4);
  p.ropes = (float*)take((size_t)S * 32 * 4);
  p.ckvb = (u16*)take((size_t)S * 256 * 2);
  p.cqb = (u16*)take((size_t)S * 384 * 2);
  p.krope = (u16*)take((size_t)S * 64 * 2);
  p.bar = (unsigned*)take(XCD_BAR_WORDS * 4);
  if (off > ws_size) { fprintf(stderr, "workspace too small: need %zu have %zu\n", off, ws_size); return; }
#if MEGA
  static int grid_blocks = 0;
  if (!grid_blocks) {
    int dev = 0, cus = 0, per_cu = 0;
    hipGetDevice(&dev);
    hipDeviceGetAttribute(&cus, hipDeviceAttributeMultiprocessorCount, dev);
    hipOccupancyMaxActiveBlocksPerMultiprocessor(&per_cu, mega_kernel, 256, 0);
    if (per_cu > 2) per_cu = 2;
    grid_blocks = cus * per_cu;
  }
  (void)hipMemsetAsync(p.bar, 0, XCD_BAR_WORDS * 4, stream);
  void* args[] = {&p};
  hipError_t e = hipLaunchCooperativeKernel((void*)mega_kernel, dim3(grid_blocks), dim3(256), args, 0, stream);
  if (e != hipSuccess) fprintf(stderr, "cooperative launch failed: %s (grid %d)\n", hipGetErrorString(e), grid_blocks);
#else
  for (int ph = 0; ph < 19; ++ph) hipLaunchKernelGGL(phase_kernel, dim3(512), dim3(256), 0, stream, p, ph);
#endif
}
```

```cpp
#include <hip/hip_runtime.h>
#include <hip/hip_cooperative_groups.h>
#include <stdint.h>
#include <cstdio>
namespace cg = cooperative_groups;

#ifndef MEGA
#define MEGA 1
#endif

#define DI __device__ __forceinline__
typedef unsigned short u16;
typedef short bf16x8 __attribute__((ext_vector_type(8)));
typedef short s16x4 __attribute__((ext_vector_type(4)));
typedef float f32x4 __attribute__((ext_vector_type(4)));
typedef float f32x16 __attribute__((ext_vector_type(16)));
typedef float f32x2 __attribute__((ext_vector_type(2)));
typedef unsigned u32x4 __attribute__((ext_vector_type(4)));
typedef unsigned u32x2 __attribute__((ext_vector_type(2)));
typedef int i32x4 __attribute__((ext_vector_type(4)));
typedef unsigned char u8;
typedef __bf16 bf2_t __attribute__((ext_vector_type(2)));

constexpr int S = 16384;
constexpr int D = 1024;
constexpr float NORM_EPS = 1e-5f;
constexpr float DN_ALPHA = 1.41421356237309515f;
constexpr int SMEM_BYTES = 73728;
constexpr int NPHASE = 20;

struct Params {
  const float *x, *p; const int* pos;
  const float *ln_g, *ln_b, *a_w_in, *a_b_if, *a_hn_g, *a_w_out, *kv_w_down, *kv_norm_g, *kv_w_up,
      *b_w_dq, *b_q_norm_g, *b_w_uq, *b_w_out, *peer_w_q, *peer_sub_keys, *peer_u, *peer_v, *ple_w_proj, *ple_w_gate;
  float* out;
  u16 *WinT, *WoaT, *WpqT, *SubK, *WgT, *WpT, *WdT, *WupT, *WuqT, *WobT, *pb;
  u8 *Uq, *Vq; float *scU, *scV;
  u8 *Xq8, *Wq8, *Wg8, *Win8; float *sxq, *swq, *swg, *swin;
  float *F1, *F2;
  u16 *B0, *B1, *B2, *B3, *B4, *B6;
  float *igf, *lf, *dn, *nprev, *blast, *mloc, *mprev, *ropec, *ropes;
  u16 *ckvb, *cqb, *krope;
  unsigned* bar;
};

DI int opaque_tid() { int t = threadIdx.x; asm volatile("" : "+v"(t)); return t; }
DI int opaque_bid() { int b = blockIdx.x; asm volatile("" : "+s"(b)); return b; }
#define TIDX opaque_tid()
#define BIDX opaque_bid()
DI unsigned pack2(float a, float b) { f32x2 v = {a, b}; bf2_t r = __builtin_convertvector(v, bf2_t); return __builtin_bit_cast(unsigned, r); }
DI u16 f2bf(float a) { return (u16)(pack2(a, 0.f) & 0xffffu); }
DI float bflo(unsigned u) { return __uint_as_float(u << 16); }
DI float bfhi(unsigned u) { return __uint_as_float(u & 0xffff0000u); }
DI float bf2f(u16 v) { return __uint_as_float(((unsigned)v) << 16); }
DI f32x4 mfma16(bf16x8 a, bf16x8 b, f32x4 c) { return __builtin_amdgcn_mfma_f32_16x16x32_bf16(a, b, c, 0, 0, 0); }
DI f32x16 mfma32(bf16x8 a, bf16x8 b, f32x16 c) { return __builtin_amdgcn_mfma_f32_32x32x16_bf16(a, b, c, 0, 0, 0); }
DI int crow(int i, int hh) { return (i & 3) + 8 * (i >> 2) + 4 * hh; }
DI float wave_sum(float v) {
#pragma unroll
  for (int o = 32; o; o >>= 1) v += __shfl_xor(v, o);
  return v;
}
DI float wave_max(float v) {
#pragma unroll
  for (int o = 32; o; o >>= 1) v = fmaxf(v, __shfl_xor(v, o));
  return v;
}
DI float sigmoidf_(float x) { return 1.f / (1.f + __expf(-x)); }
DI float logsigmoidf_(float x) { return fminf(x, 0.f) - log1pf(__expf(-fabsf(x))); }
DI bf16x8 pack8(float a0, float a1, float a2, float a3, float a4, float a5, float a6, float a7) {
  uint4 u; u.x = pack2(a0, a1); u.y = pack2(a2, a3); u.z = pack2(a4, a5); u.w = pack2(a6, a7);
  return __builtin_bit_cast(bf16x8, u);
}

DI void tconv_tile(const float* __restrict__ src, int lds, int K, int c0, int nc, u16* __restrict__ dst, int r0,
                   const float* __restrict__ g, float sc, int ti, char* smem) {
  float (*t)[65] = (float (*)[65])smem;
  const int tid = TIDX;
  const int nct = (nc + 63) / 64;
  const int kt = ti / nct, ct = ti % nct;
  __syncthreads();
#pragma unroll
  for (int r = 0; r < 16; ++r) {
    const int k = r * 4 + (tid >> 6), n = tid & 63;
    const int col = ct * 64 + n;
    float v = 0.f;
    if (col < nc) v = src[(size_t)(kt * 64 + k) * lds + c0 + col];
    if (g) v *= g[kt * 64 + k];
    t[k][n] = v * sc;
  }
  __syncthreads();
#pragma unroll
  for (int r = 0; r < 16; ++r) {
    const int n = r * 4 + (tid >> 6), k = tid & 63;
    const int col = ct * 64 + n;
    if (col < nc) dst[(size_t)(r0 + col) * K + kt * 64 + k] = f2bf(t[k][n]);
  }
}
DI void cvt_job(const float* __restrict__ src, u16* __restrict__ dst, size_t n) {
  const size_t n4 = n >> 2;
  const size_t stride = (size_t)gridDim.x * 256;
  for (size_t i = (size_t)BIDX * 256 + TIDX; i < n4; i += stride * 8) {
    float4 v[8];
#pragma unroll
    for (int u = 0; u < 8; ++u) if (i + u * stride < n4) { const f32x4 t_ = __builtin_nontemporal_load((const f32x4*)src + i + u * stride); v[u] = make_float4(t_[0], t_[1], t_[2], t_[3]); }
#pragma unroll
    for (int u = 0; u < 8; ++u) if (i + u * stride < n4) {
      uint2 o; o.x = pack2(v[u].x, v[u].y); o.y = pack2(v[u].z, v[u].w);
      ((uint2*)dst)[i + u * stride] = o;
    }
  }
}
DI void zero_job(u16* __restrict__ dst, size_t n) {
  for (size_t i = (size_t)BIDX * 256 + TIDX; i < n; i += (size_t)gridDim.x * 256) dst[i] = 0;
}

DI unsigned q8(float v, float inv, int bias) { int q = (int)rintf(v * inv); q = q < -127 ? -127 : (q > 127 ? 127 : q); return (unsigned)(q + bias) & 0xffu; }
DI unsigned q8x4(float4 v, float inv, int bias) { return q8(v.x, inv, bias) | (q8(v.y, inv, bias) << 8) | (q8(v.z, inv, bias) << 16) | (q8(v.w, inv, bias) << 24); }
DI float absmax4(float4 v) { return fmaxf(fmaxf(fabsf(v.x), fabsf(v.y)), fmaxf(fabsf(v.z), fabsf(v.w))); }
DI void quant_rows(const float* __restrict__ src, u8* __restrict__ dst, float* __restrict__ scale, int nrows, int bias, int vb, int nvb) {
  const int lane = TIDX & 63, wave = TIDX >> 6;
  for (int row0 = vb * 4 + wave; row0 < nrows; row0 += nvb * 16) {
    float4 v[4][4];
#pragma unroll
    for (int u = 0; u < 4; ++u) {
      const int row = row0 + u * nvb * 4;
      if (row < nrows) {
        const f32x4* r = (const f32x4*)(src + (size_t)row * 1024 + lane * 16);
#pragma unroll
        for (int k = 0; k < 4; ++k) { const f32x4 t_ = __builtin_nontemporal_load(r + k); v[u][k] = make_float4(t_[0], t_[1], t_[2], t_[3]); }
      }
    }
#pragma unroll
    for (int u = 0; u < 4; ++u) {
      const int row = row0 + u * nvb * 4;
      if (row < nrows) {
        float mx = fmaxf(fmaxf(absmax4(v[u][0]), absmax4(v[u][1])), fmaxf(absmax4(v[u][2]), absmax4(v[u][3])));
        mx = wave_max(mx);
        const float sc = mx > 0.f ? mx * (1.f / 127.f) : 1.f;
        const float inv = 1.f / sc;
        u32x4 o; o[0] = q8x4(v[u][0], inv, bias); o[1] = q8x4(v[u][1], inv, bias); o[2] = q8x4(v[u][2], inv, bias); o[3] = q8x4(v[u][3], inv, bias);
        *(u32x4*)(dst + (size_t)row * 1024 + lane * 16) = o;
        if (lane == 0) scale[row] = sc;
      }
    }
  }
}

DI void wq_tile(const float* __restrict__ src, int lds, int c0, u8* __restrict__ dst, float* __restrict__ scale, int r0, float mult, int ti, char* smem) {
  float (*t)[17] = (float (*)[17])smem;
  float* red = (float*)(smem + 1024 * 17 * 4);
  const int tid = TIDX;
  const int n = tid & 15, kq = tid >> 4;
  __syncthreads();
  float mx = 0.f;
#pragma unroll 8
  for (int kk = 0; kk < 64; ++kk) {
    const int k = kk * 16 + kq;
    const float v = src[(size_t)k * lds + c0 + ti * 16 + n];
    t[k][n] = v;
    mx = fmaxf(mx, fabsf(v));
  }
  red[kq * 16 + n] = mx;
  __syncthreads();
  if (tid < 16) {
    float m2 = 0.f;
#pragma unroll
    for (int j = 0; j < 16; ++j) m2 = fmaxf(m2, red[j * 16 + tid]);
    const float sc = m2 > 0.f ? m2 * (1.f / 127.f) : 1.f;
    red[256 + tid] = 1.f / sc;
    scale[r0 + ti * 16 + tid] = sc * mult;
  }
  __syncthreads();
  {
    const int nn = tid >> 4, ks = (tid & 15) * 64;
    const float inv = red[256 + nn];
    u8* d = dst + (size_t)(r0 + ti * 16 + nn) * 1024 + ks;
#pragma unroll
    for (int j = 0; j < 4; ++j) {
      u32x4 o;
#pragma unroll
      for (int w = 0; w < 4; ++w) {
        const int k = ks + j * 16 + w * 4;
        o[w] = q8(t[k][nn], inv, 0) | (q8(t[k + 1][nn], inv, 0) << 8) | (q8(t[k + 2][nn], inv, 0) << 16) | (q8(t[k + 3][nn], inv, 0) << 24);
      }
      *(u32x4*)(d + j * 16) = o;
    }
  }
}

DI void quant_rows_bf16(const u16* __restrict__ src, u8* __restrict__ dst, float* __restrict__ scale, int nrows, int vb, int nvb) {
  const int lane = TIDX & 63, wave = TIDX >> 6;
  for (int row = vb * 4 + wave; row < nrows; row += nvb * 4) {
    const uint4 a = *(const uint4*)(src + (size_t)row * 1024 + lane * 16), b = *(const uint4*)(src + (size_t)row * 1024 + lane * 16 + 8);
    const float4 v0 = make_float4(bflo(a.x), bfhi(a.x), bflo(a.y), bfhi(a.y)), v1 = make_float4(bflo(a.z), bfhi(a.z), bflo(a.w), bfhi(a.w));
    const float4 v2 = make_float4(bflo(b.x), bfhi(b.x), bflo(b.y), bfhi(b.y)), v3 = make_float4(bflo(b.z), bfhi(b.z), bflo(b.w), bfhi(b.w));
    float mx = fmaxf(fmaxf(absmax4(v0), absmax4(v1)), fmaxf(absmax4(v2), absmax4(v3)));
    mx = wave_max(mx);
    const float sc = mx > 0.f ? mx * (1.f / 127.f) : 1.f;
    const float inv = 1.f / sc;
    u32x4 o; o[0] = q8x4(v0, inv, 0); o[1] = q8x4(v1, inv, 0); o[2] = q8x4(v2, inv, 0); o[3] = q8x4(v3, inv, 0);
    *(u32x4*)(dst + (size_t)row * 1024 + lane * 16) = o;
    if (lane == 0) scale[row] = sc;
  }
}

DI void phase_prologue(const Params& p, char* smem) {
#define TJOB(src, lds, K, c0, nc, dst, r0, g, sc) { const int nt__ = (((nc) + 63) / 64) * ((K) / 64); \
    if (ti >= base && ti < base + nt__) tconv_tile(src, lds, K, c0, nc, dst, r0, g, sc, ti - base, smem); base += nt__; }
  for (int ti = BIDX;; ti += gridDim.x) {
    int base = 0;
#define WJOB(c0, nc, r0, mult) { const int nt__ = (nc) / 16; \
    if (ti >= base && ti < base + nt__) wq_tile(p.a_w_in, 3088, c0, p.Win8, p.swin, r0, mult, ti - base, smem); base += nt__; }
    WJOB(0, 512, 0, 1.f)
    WJOB(512, 512, 512, 0.125f)
    WJOB(1024, 1024, 1024, 1.f)
    WJOB(2064, 1024, 2048, 1.f)
    WJOB(2048, 16, 3072, 1.f)
#undef WJOB
    TJOB(p.a_w_out, 1024, 1024, 0, 1024, p.WoaT, 0, nullptr, 1.f)
    TJOB(p.peer_w_q, 2048, 1024, 0, 2048, p.WpqT, 0, nullptr, 1.f)
    TJOB(p.peer_w_q + (size_t)1024 * 2048, 2048, 1024, 0, 2048, p.WpqT + (size_t)2048 * 1024, 0, nullptr, 1.f)
    TJOB(p.ple_w_gate, 1024, 1024, 0, 1024, p.WgT, 0, nullptr, 1.f)
    TJOB(p.ple_w_gate + (size_t)1024 * 1024, 1024, 1024, 0, 1024, p.WgT + (size_t)1024 * 1024, 0, nullptr, 1.f)
    TJOB(p.ple_w_proj, 1024, 256, 0, 1024, p.WpT, 0, nullptr, 1.f)
    TJOB(p.ple_w_proj + (size_t)256 * 1024, 1024, 256, 0, 1024, p.WpT + (size_t)1024 * 256, 0, nullptr, 1.f)
    TJOB(p.kv_w_down, 320, 1024, 0, 256, p.WdT, 0, nullptr, 1.f)
    TJOB(p.b_w_dq, 384, 1024, 0, 384, p.WdT, 256, nullptr, 1.f)
    TJOB(p.kv_w_down, 320, 1024, 256, 64, p.WdT, 640, nullptr, 1.f)
    TJOB(p.kv_w_up, 2048, 256, 0, 2048, p.WupT, 0, p.kv_norm_g, 1.f)
    TJOB(p.b_w_uq, 1536, 384, 0, 1536, p.WuqT, 0, p.b_q_norm_g, 0.07216878364870322f * 1.4426950408889634f)
    TJOB(p.b_w_out, 1024, 1024, 0, 1024, p.WobT, 0, nullptr, 1.f)
    if (ti >= base) break;
  }
#undef TJOB
  zero_job((u16*)(p.Win8 + (size_t)3088 * 1024), (size_t)112 * 512);
  for (int i = BIDX * 256 + TIDX; i < 112; i += gridDim.x * 256) p.swin[3088 + i] = 0.f;
  zero_job(p.WdT + (size_t)704 * 1024, (size_t)64 * 1024);
  cvt_job(p.peer_sub_keys, p.SubK, (size_t)2 * 8 * 2 * 128 * 128);
  quant_rows(p.x, p.Xq8, p.sxq, S, 0, BIDX, gridDim.x);
  cvt_job(p.p, p.pb, (size_t)2 * S * 256);
  for (int i = BIDX * 256 + TIDX; i < S * 32; i += gridDim.x * 256) {
    const int m = i >> 5, f = i & 31;
    const float invf = powf(10000.f, -(float)(2 * f) / 64.f);
    const float ang = (float)p.pos[m] * invf;
    const double a = (double)ang;
    const double n = rint(a * 0.63661977236758134308);
    double r = fma(-n, 1.57079632679489655800, a);
    r = fma(-n, 6.12323399573676603587e-17, r);
    const double r2 = r * r;
    double sn = r * (1.0 + r2 * (-1.0 / 6 + r2 * (1.0 / 120 + r2 * (-1.0 / 5040 + r2 * (1.0 / 362880 + r2 * (-1.0 / 39916800 + r2 * (1.0 / 6227020800.0)))))));
    double cs = 1.0 + r2 * (-0.5 + r2 * (1.0 / 24 + r2 * (-1.0 / 720 + r2 * (1.0 / 40320 + r2 * (-1.0 / 3628800 + r2 * (1.0 / 479001600.0 + r2 * (-1.0 / 87178291200.0)))))));
    const int q = ((int)n) & 3;
    double c2, s2;
    if (q == 0) { c2 = cs; s2 = sn; } else if (q == 1) { c2 = -sn; s2 = cs; } else if (q == 2) { c2 = -cs; s2 = -sn; } else { c2 = sn; s2 = -cs; }
    p.ropec[i] = (float)c2; p.ropes[i] = (float)s2;
  }
}

#define GLDS16(src, dst) __builtin_amdgcn_global_load_lds((const unsigned*)(src), (__attribute__((address_space(3))) unsigned*)(dst), 16, 0, 0)
DI void gemm_core(const u16* __restrict__ P, int ldp, const u16* __restrict__ Q, int ldq, int K, int p0, int q0,
                  char* smem, f32x4 (&acc)[4][4]) {
  const int tid = TIDX, lane = tid & 63, wave = tid >> 6;
  const int wp = wave >> 1, wq = wave & 1;
  const u16* pu = P + (size_t)p0 * ldp;
  const u16* qu = Q + (size_t)q0 * ldq;
  int offp[4], offq[4];
#pragma unroll
  for (int i = 0; i < 4; ++i) {
    const int row = wave * 32 + i * 8 + (lane >> 3);
    const int g = (lane & 7) ^ ((row >> 1) & 7);
    offp[i] = row * ldp + g * 8;
    offq[i] = row * ldq + g * 8;
  }
  const int swz = (lane & 15) >> 1;
  const int ra_base = (wp * 64 + (lane & 15)) * 128, rb_base = 16384 + (wq * 64 + (lane & 15)) * 128;
  const int KT = K >> 6;
  __syncthreads();
#pragma unroll
  for (int i = 0; i < 4; ++i) {
    GLDS16(pu + offp[i], smem + (wave * 4 + i) * 1024);
    GLDS16(qu + offq[i], smem + 16384 + (wave * 4 + i) * 1024);
  }
  for (int kt = 0; kt < KT; ++kt) {
    asm volatile("s_waitcnt vmcnt(0)" ::: "memory");
    __syncthreads();
    if (kt + 1 < KT) {
      char* sn = smem + ((kt + 1) & 1) * 32768;
#pragma unroll
      for (int i = 0; i < 4; ++i) {
        GLDS16(pu + (kt + 1) * 64 + offp[i], sn + (wave * 4 + i) * 1024);
        GLDS16(qu + (kt + 1) * 64 + offq[i], sn + 16384 + (wave * 4 + i) * 1024);
      }
    }
    const char* sc = smem + (kt & 1) * 32768;
#pragma unroll
    for (int ks = 0; ks < 2; ++ks) {
      bf16x8 fa[4], fb[4];
      const int gofs = ((ks * 4 + (lane >> 4)) ^ swz) * 16;
#pragma unroll
      for (int mt = 0; mt < 4; ++mt) fa[mt] = *(const bf16x8*)(sc + ra_base + mt * 2048 + gofs);
#pragma unroll
      for (int nt = 0; nt < 4; ++nt) fb[nt] = *(const bf16x8*)(sc + rb_base + nt * 2048 + gofs);
#pragma unroll
      for (int mt = 0; mt < 4; ++mt)
#pragma unroll
        for (int nt = 0; nt < 4; ++nt) acc[mt][nt] = mfma16(fa[mt], fb[nt], acc[mt][nt]);
    }
  }
  __syncthreads();
}
typedef int i32x4_t __attribute__((ext_vector_type(4)));
DI void gemm_core_i8(const u8* __restrict__ P, int ldp, const u8* __restrict__ Q, int ldq, int K, int p0, int q0,
                     char* smem, i32x4_t (&acc)[4][4]) {
  const int tid = TIDX, lane = tid & 63, wave = tid >> 6;
  const int wp = wave >> 1, wq = wave & 1;
  const u8* pu = P + (size_t)p0 * ldp;
  const u8* qu = Q + (size_t)q0 * ldq;
  int offp[4], offq[4];
#pragma unroll
  for (int i = 0; i < 4; ++i) {
    const int row = wave * 32 + i * 8 + (lane >> 3);
    const int g = (lane & 7) ^ ((row >> 1) & 7);
    offp[i] = row * ldp + g * 16;
    offq[i] = row * ldq + g * 16;
  }
  const int swz = (lane & 15) >> 1;
  const int ra_base = (wp * 64 + (lane & 15)) * 128, rb_base = 16384 + (wq * 64 + (lane & 15)) * 128;
  const int KT = K >> 7;
  __syncthreads();
#pragma unroll
  for (int i = 0; i < 4; ++i) {
    GLDS16(pu + offp[i], smem + (wave * 4 + i) * 1024);
    GLDS16(qu + offq[i], smem + 16384 + (wave * 4 + i) * 1024);
  }
  for (int kt = 0; kt < KT; ++kt) {
    asm volatile("s_waitcnt vmcnt(0)" ::: "memory");
    __syncthreads();
    if (kt + 1 < KT) {
      char* sn = smem + ((kt + 1) & 1) * 32768;
#pragma unroll
      for (int i = 0; i < 4; ++i) {
        GLDS16(pu + (kt + 1) * 128 + offp[i], sn + (wave * 4 + i) * 1024);
        GLDS16(qu + (kt + 1) * 128 + offq[i], sn + 16384 + (wave * 4 + i) * 1024);
      }
    }
    const char* sc = smem + (kt & 1) * 32768;
#pragma unroll
    for (int ks = 0; ks < 2; ++ks) {
      i32x4_t fa[4], fb[4];
      const int gofs = ((ks * 4 + (lane >> 4)) ^ swz) * 16;
#pragma unroll
      for (int mt = 0; mt < 4; ++mt) fa[mt] = *(const i32x4_t*)(sc + ra_base + mt * 2048 + gofs);
#pragma unroll
      for (int nt = 0; nt < 4; ++nt) fb[nt] = *(const i32x4_t*)(sc + rb_base + nt * 2048 + gofs);
#pragma unroll
      for (int mt = 0; mt < 4; ++mt)
#pragma unroll
        for (int nt = 0; nt < 4; ++nt) acc[mt][nt] = __builtin_amdgcn_mfma_i32_16x16x64_i8(fa[mt], fb[nt], acc[mt][nt], 0, 0, 0);
    }
  }
  __syncthreads();
}
DI void zero_acc(f32x4 (&acc)[4][4]) {
#pragma unroll
  for (int a = 0; a < 4; ++a)
#pragma unroll
    for (int b = 0; b < 4; ++b) acc[a][b] = f32x4{0.f, 0.f, 0.f, 0.f};
}
#define EPI_IDX                                                        \
  const int lane = TIDX & 63, wave = TIDX >> 6;          \
  const int pb_ = p0 + (wave >> 1) * 64 + (lane >> 4) * 4;             \
  const int qb_ = q0 + (wave & 1) * 64 + (lane & 15);

DI void store4bf(u16* dst, float a, float b, float c, float d) { uint2 o; o.x = pack2(a, b); o.y = pack2(c, d); *(uint2*)dst = o; }

DI void stage_acc(f32x4 (&acc)[4][4], char* smem) {
  const int t = TIDX, lane = t & 63, wave = t >> 6;
  float* st = (float*)smem;
  const int pl = (wave >> 1) * 64 + (lane >> 4) * 4, ql = (wave & 1) * 64 + (lane & 15);
#pragma unroll
  for (int a = 0; a < 4; ++a)
#pragma unroll
    for (int b = 0; b < 4; ++b) *(f32x4*)(st + (ql + b * 16) * 132 + pl + a * 16) = acc[a][b];
}
#define EPI_BEGIN                                                                                  \
  stage_acc(acc, smem);                                                                            \
  __syncthreads();                                                                                 \
  {                                                                                                \
    const int et_ = TIDX;                                                                          \
    _Pragma("unroll 4") for (int ej_ = 0; ej_ < 16; ++ej_) {                                       \
      const int er_ = (et_ >> 5) + 8 * ej_, ec_ = (et_ & 31) * 4;                                  \
      const f32x4 ev_ = *(const f32x4*)((const float*)smem + er_ * 132 + ec_);                     \
      const int pb_ = p0 + ec_, qb_ = q0 + er_;
#define EPI_END }}

struct TileIter { int band, j, G, MTB; };
DI TileIter tile_iter_init() {
  TileIter t;
  if ((gridDim.x & 7) == 0) { t.band = BIDX & 7; t.j = BIDX >> 3; t.G = gridDim.x >> 3; t.MTB = 16; }
  else { t.band = 0; t.j = BIDX; t.G = gridDim.x; t.MTB = 128; }
  return t;
}
DI bool tile_of(const TileIter& t, int q, int NT, int& mt, int& nt) {
  const int full = NT >> 3, rem = NT & 7;
  const int per_full = t.MTB * 8;
  const int ng = q / per_full;
  if (ng < full) {
    const int r = q - ng * per_full, mh = r >> 6, r2 = r & 63;
    nt = ng * 8 + (r2 >> 3); mt = t.band * t.MTB + mh * 8 + (r2 & 7);
    return true;
  }
  q -= full * per_full;
  if (rem == 0 || q >= t.MTB * rem) return false;
  nt = full * 8 + q % rem; mt = t.band * t.MTB + q / rem;
  return true;
}
#define TILE_LOOP(NT) const TileIter tit_ = tile_iter_init(); int mt_, nt_; for (int q_ = tit_.j; tile_of(tit_, q_, (NT), mt_, nt_); q_ += tit_.G)


DI void gemm_core2(const u16* __restrict__ P, int ldp, const u16* __restrict__ Q, int ldq, int K, int p0, int q0,
                   char* smem, f32x4 (&acc)[4][8]) {
  const int tid = TIDX, lane = tid & 63, wave = tid >> 6;
  const int wp = wave >> 1, wq = wave & 1;
  const u16* pu = P + (size_t)p0 * ldp;
  const u16* qu = Q + (size_t)q0 * ldq;
  const int gd = (lane & 3) ^ ((lane >> 4) & 3);
  int offp[2], offq[4];
#pragma unroll
  for (int i = 0; i < 2; ++i) offp[i] = ((wave * 2 + i) * 16 + (lane >> 2)) * ldp + gd * 8;
#pragma unroll
  for (int i = 0; i < 4; ++i) offq[i] = ((wave * 4 + i) * 16 + (lane >> 2)) * ldq + gd * 8;
  const int pos16 = ((lane >> 4) ^ ((lane >> 2) & 3)) * 16;
  const int ra_base = (wp * 64 + (lane & 15)) * 64 + pos16, rb_base = 8192 + (wq * 128 + (lane & 15)) * 64 + pos16;
  const int KT = K >> 5;
  auto issue = [&](int kt, int st) {
    char* sn = smem + st * 24576;
#pragma unroll
    for (int i = 0; i < 2; ++i) GLDS16(pu + kt * 32 + offp[i], sn + (wave * 2 + i) * 1024);
#pragma unroll
    for (int i = 0; i < 4; ++i) GLDS16(qu + kt * 32 + offq[i], sn + 8192 + (wave * 4 + i) * 1024);
  };
  __syncthreads();
  issue(0, 0); issue(1, 1);
  int st = 0;
  for (int kt = 0; kt < KT; ++kt) {
    if (kt + 1 < KT) asm volatile("s_waitcnt vmcnt(6)" ::: "memory");
    else asm volatile("s_waitcnt vmcnt(0)" ::: "memory");
    asm volatile("s_waitcnt lgkmcnt(0)" ::: "memory");
    __builtin_amdgcn_s_barrier();
    if (kt + 2 < KT) issue(kt + 2, st >= 1 ? st - 1 : 2);
    const char* sc = smem + st * 24576;
    bf16x8 fa[4], fb[8];
#pragma unroll
    for (int mt = 0; mt < 4; ++mt) fa[mt] = *(const bf16x8*)(sc + ra_base + mt * 1024);
#pragma unroll
    for (int nt = 0; nt < 8; ++nt) fb[nt] = *(const bf16x8*)(sc + rb_base + nt * 1024);
#pragma unroll
    for (int mt = 0; mt < 4; ++mt)
#pragma unroll
      for (int nt = 0; nt < 8; ++nt) acc[mt][nt] = mfma16(fa[mt], fb[nt], acc[mt][nt]);
    st = (st == 2) ? 0 : st + 1;
  }
  __syncthreads();
}
DI void zero_acc2(f32x4 (&acc)[4][8]) {
#pragma unroll
  for (int a = 0; a < 4; ++a)
#pragma unroll
    for (int b = 0; b < 8; ++b) acc[a][b] = f32x4{0.f, 0.f, 0.f, 0.f};
}
DI void stage_acc2(f32x4 (&acc)[4][8], char* smem, int half) {
  const int t = TIDX, lane = t & 63, wave = t >> 6;
  if ((wave & 1) != half) return;
  float* st = (float*)smem;
  const int pl = (wave >> 1) * 64 + (lane >> 4) * 4, ql = (lane & 15);
#pragma unroll
  for (int a = 0; a < 4; ++a)
#pragma unroll
    for (int b = 0; b < 8; ++b) *(f32x4*)(st + (ql + b * 16) * 132 + pl + a * 16) = acc[a][b];
}
#define EPI2_BEGIN                                                                                 \
  for (int eh_ = 0; eh_ < 2; ++eh_) {                                                              \
    __syncthreads();                                                                               \
    stage_acc2(acc, smem, eh_);                                                                    \
    __syncthreads();                                                                               \
    const int et_ = TIDX;                                                                          \
    _Pragma("unroll 4") for (int ej_ = 0; ej_ < 16; ++ej_) {                                       \
      const int er_ = (et_ >> 5) + 8 * ej_, ec_ = (et_ & 31) * 4;                                  \
      const f32x4 ev_ = *(const f32x4*)((const float*)smem + er_ * 132 + ec_);                     \
      const int pb_ = p0 + ec_, qb_ = q0 + eh_ * 128 + er_;
#define EPI2_END }}
#define TILE_LOOP2(NT) TileIter tit_ = tile_iter_init(); tit_.MTB >>= 1; int mt_, nt_; for (int q_ = tit_.j; tile_of(tit_, q_, (NT), mt_, nt_); q_ += tit_.G)

DI void phase_inproj(const Params& p, char* smem) {
  u16* q_ml = p.B2; u16* k_ml = p.B2 + (size_t)S * 512; u16* kT = p.B6; u16* vT = p.B3; u16* og = p.B4;
  TILE_LOOP(25) {
    f32x4 acc[4][4];
    i32x4_t iacc[4][4];
#pragma unroll
    for (int a = 0; a < 4; ++a)
#pragma unroll
      for (int b = 0; b < 4; ++b) iacc[a][b] = i32x4_t{0, 0, 0, 0};
    const int lane_ = TIDX & 63, wave_ = TIDX >> 6;
    if (nt_ >= 8 && nt_ < 16) {
      const int p0 = mt_ * 128, q0 = nt_ * 128;
      gemm_core_i8(p.Xq8, 1024, p.Win8, 1024, 1024, p0, q0, smem, iacc);
      const int mb_ = p0 + (wave_ >> 1) * 64 + (lane_ >> 4) * 4, nb_ = q0 + (wave_ & 1) * 64 + (lane_ & 15);
#pragma unroll
      for (int a = 0; a < 4; ++a) {
        const float4 sxv = *(const float4*)(p.sxq + mb_ + a * 16);
#pragma unroll
        for (int b = 0; b < 4; ++b) {
          const float swv = p.swin[nb_ + b * 16];
          acc[a][b][0] = (float)iacc[a][b][0] * sxv.x * swv; acc[a][b][1] = (float)iacc[a][b][1] * sxv.y * swv;
          acc[a][b][2] = (float)iacc[a][b][2] * sxv.z * swv; acc[a][b][3] = (float)iacc[a][b][3] * sxv.w * swv;
        }
      }
      EPI_BEGIN
        store4bf(vT + (size_t)(qb_ - 1024) * S + pb_, ev_[0], ev_[1], ev_[2], ev_[3]);
      EPI_END
    } else {
      const int p0 = nt_ * 128, q0 = mt_ * 128;
      gemm_core_i8(p.Win8, 1024, p.Xq8, 1024, 1024, p0, q0, smem, iacc);
      const int nb_ = p0 + (wave_ >> 1) * 64 + (lane_ >> 4) * 4, mb_ = q0 + (wave_ & 1) * 64 + (lane_ & 15);
#pragma unroll
      for (int a = 0; a < 4; ++a) {
        const float4 swv = *(const float4*)(p.swin + nb_ + a * 16);
#pragma unroll
        for (int b = 0; b < 4; ++b) {
          const float sxv = p.sxq[mb_ + b * 16];
          acc[a][b][0] = (float)iacc[a][b][0] * swv.x * sxv; acc[a][b][1] = (float)iacc[a][b][1] * swv.y * sxv;
          acc[a][b][2] = (float)iacc[a][b][2] * swv.z * sxv; acc[a][b][3] = (float)iacc[a][b][3] * swv.w * sxv;
        }
      }
      EPI_BEGIN
        const int n = pb_, m = qb_;
        if (nt_ < 4) {
          store4bf(q_ml + (size_t)m * 512 + n, ev_[0], ev_[1], ev_[2], ev_[3]);
        } else if (nt_ < 8) {
          store4bf(k_ml + (size_t)m * 512 + n - 512, ev_[0], ev_[1], ev_[2], ev_[3]);
        } else if (nt_ < 24) {
          store4bf(og + (size_t)m * 1024 + n - 2048, sigmoidf_(ev_[0]), sigmoidf_(ev_[1]), sigmoidf_(ev_[2]), sigmoidf_(ev_[3]));
        } else {
          const int nn = n - 3072;
          if (nn < 8) {
#pragma unroll
            for (int i = 0; i < 4; ++i) p.igf[m * 8 + nn + i] = ev_[i] + p.a_b_if[nn + i];
          } else if (nn < 16) {
#pragma unroll
            for (int i = 0; i < 4; ++i) p.lf[m * 8 + nn - 8 + i] = logsigmoidf_(ev_[i] + p.a_b_if[nn + i]);
          }
        }
      EPI_END
      if (nt_ >= 4 && nt_ < 8) {
        const int et = TIDX;
        const float* st = (const float*)smem;
#pragma unroll 4
        for (int ej = 0; ej < 16; ++ej) {
          const int nl = (et >> 5) + 8 * ej, ml = (et & 31) * 4;
          store4bf(kT + (size_t)(p0 - 512 + nl) * S + q0 + ml, st[ml * 132 + nl], st[(ml + 1) * 132 + nl], st[(ml + 2) * 132 + nl], st[(ml + 3) * 132 + nl]);
        }
      }
    }
  }
}


DI void phase_ml_local(const Params& p, char* smem) {
  float* sw = (float*)smem;
  const u16* kT = p.B6; const u16* vT = p.B3; float* dC = p.F2;
  const int tid = TIDX, lane = tid & 63, wave = tid >> 6;
  const int r = lane & 31, hh = lane >> 5;
  for (int it = BIDX; it < 2048; it += gridDim.x) {
    const int c = it >> 3, h = it & 7;
    __syncthreads();
    if (wave == 0) {
      const int t = c * 64 + lane;
      const float lfv = p.lf[t * 8 + h], igv = p.igf[t * 8 + h];
      float b = lfv;
#pragma unroll
      for (int o = 1; o < 64; o <<= 1) { float y = __shfl_up(b, o); if (lane >= o) b += y; }
      const float bl = __shfl(b, 63);
      const float ls = bl - b + igv;
      const float mx = wave_max(ls);
      sw[lane] = __expf(ls - mx);
      if (lane == 0) { p.blast[it] = bl; p.mloc[it] = mx; }
    }
    __syncthreads();
    f32x16 acc0, acc1;
#pragma unroll
    for (int i = 0; i < 16; ++i) { acc0[i] = 0.f; acc1[i] = 0.f; }
    const u16* va = vT + (size_t)(h * 128 + wave * 32 + r) * S + c * 64 + hh * 8;
    const u16* kb0 = kT + (size_t)(h * 64 + r) * S + c * 64 + hh * 8;
    const u16* kb1 = kb0 + (size_t)32 * S;
#pragma unroll
    for (int ks = 0; ks < 4; ++ks) {
      const bf16x8 a = *(const bf16x8*)(va + ks * 16);
      const uint4 k0 = *(const uint4*)(kb0 + ks * 16), k1 = *(const uint4*)(kb1 + ks * 16);
      const float* w = sw + ks * 16 + hh * 8;
      const bf16x8 b0 = pack8(bflo(k0.x) * w[0], bfhi(k0.x) * w[1], bflo(k0.y) * w[2], bfhi(k0.y) * w[3],
                              bflo(k0.z) * w[4], bfhi(k0.z) * w[5], bflo(k0.w) * w[6], bfhi(k0.w) * w[7]);
      const bf16x8 b1 = pack8(bflo(k1.x) * w[0], bfhi(k1.x) * w[1], bflo(k1.y) * w[2], bfhi(k1.y) * w[3],
                              bflo(k1.z) * w[4], bfhi(k1.z) * w[5], bflo(k1.w) * w[6], bfhi(k1.w) * w[7]);
      acc0 = mfma32(a, b0, acc0);
      acc1 = mfma32(a, b1, acc1);
    }
    float* dst = dC + (size_t)it * 8192;
#pragma unroll
    for (int i = 0; i < 16; ++i) {
      const int dv = wave * 32 + crow(i, hh);
      dst[dv * 64 + r] = acc0[i];
      dst[dv * 64 + 32 + r] = acc1[i];
    }
    if (tid < 64) {
      const u16* kr = kT + (size_t)(h * 64 + tid) * S + c * 64;
      float s = 0.f;
#pragma unroll
      for (int j = 0; j < 8; ++j) {
        const uint4 kk = *(const uint4*)(kr + j * 8);
        const float* w = sw + j * 8;
        s += bflo(kk.x) * w[0] + bfhi(kk.x) * w[1] + bflo(kk.y) * w[2] + bfhi(kk.y) * w[3] +
             bflo(kk.z) * w[4] + bfhi(kk.z) * w[5] + bflo(kk.w) * w[6] + bfhi(kk.w) * w[7];
      }
      p.dn[it * 64 + tid] = s;
    }
  }
}

DI void phase_ml_scan(const Params& p) {
  const float* __restrict__ dC = p.F2; u16* __restrict__ Cb = p.B1;
  const int total = 8 * 8256, half = total / 2;
  const int nscan = half / 256;
  const int bid = BIDX;
  const bool split = (int)gridDim.x > nscan + 32;
  if (split && bid >= nscan) {
    quant_rows(p.peer_u, p.Uq, p.scU, 2 * 16384, 0, bid - nscan, gridDim.x - nscan);
    quant_rows(p.peer_v, p.Vq, p.scV, 2 * 16384, 0, bid - nscan, gridDim.x - nscan);
    quant_rows_bf16(p.WpqT, p.Wq8, p.swq, 2 * 2048, bid - nscan, gridDim.x - nscan);
    quant_rows_bf16(p.WgT, p.Wg8, p.swg, 2 * 1024, bid - nscan, gridDim.x - nscan);
    return;
  }
  const int nsb = split ? nscan : (int)gridDim.x;
  for (int g = bid * 256 + TIDX; g < half; g += nsb * 256) {
    const int hA = g / 8256, eA = g % 8256, hB = hA + 4, eB = eA;
    const bool isC = eA < 8192;
    float mA = 0.f, CA = 0.f, mB = 0.f, CB = 0.f;
    for (int c0 = 0; c0 < 256; c0 += 8) {
      float dA[8], blA[8], mlA[8], dB[8], blB[8], mlB[8];
#pragma unroll
      for (int j = 0; j < 8; ++j) {
        const int itA = (c0 + j) * 8 + hA, itB = (c0 + j) * 8 + hB;
        dA[j] = isC ? dC[(size_t)itA * 8192 + eA] : p.dn[itA * 64 + eA - 8192];
        dB[j] = isC ? dC[(size_t)itB * 8192 + eB] : p.dn[itB * 64 + eB - 8192];
        blA[j] = p.blast[itA]; mlA[j] = p.mloc[itA];
        blB[j] = p.blast[itB]; mlB[j] = p.mloc[itB];
      }
#pragma unroll
      for (int j = 0; j < 8; ++j) {
        const int itA = (c0 + j) * 8 + hA, itB = (c0 + j) * 8 + hB;
        if (isC) { Cb[(size_t)itA * 8192 + eA] = f2bf(CA); Cb[(size_t)itB * 8192 + eB] = f2bf(CB); }
        else { p.nprev[itA * 64 + eA - 8192] = CA; p.nprev[itB * 64 + eB - 8192] = CB; }
        if (eA == 0) { p.mprev[itA] = mA; p.mprev[itB] = mB; }
        const float mnA = fmaxf(blA[j] + mA, mlA[j]);
        CA = __expf(blA[j] + mA - mnA) * CA + __expf(mlA[j] - mnA) * dA[j];
        mA = mnA;
        const float mnB = fmaxf(blB[j] + mB, mlB[j]);
        CB = __expf(blB[j] + mB - mnB) * CB + __expf(mlB[j] - mnB) * dB[j];
        mB = mnB;
      }
    }
  }
  if (!split) {
    quant_rows(p.peer_u, p.Uq, p.scU, 2 * 16384, 0, bid, gridDim.x);
    quant_rows(p.peer_v, p.Vq, p.scV, 2 * 16384, 0, bid, gridDim.x);
    quant_rows_bf16(p.WpqT, p.Wq8, p.swq, 2 * 2048, bid, gridDim.x);
    quant_rows_bf16(p.WgT, p.Wg8, p.swg, 2 * 1024, bid, gridDim.x);
  }
}

DI void phase_ml_out(const Params& p, char* smem) {
  const u16* q_ml = p.B2; const u16* k_ml = p.B2 + (size_t)S * 512; const u16* vT = p.B3; const u16* og = p.B4;
  const u16* Cb = p.B1; u16* hout = p.B0;
  const int tid = TIDX, lane = tid & 63, wave = tid >> 6;
  float* sA = (float*)smem + wave * 192;
  const int r = lane & 31, hh = lane >> 5;
  for (int bi = BIDX; bi < 1024; bi += gridDim.x) {
    const int it = bi * 2 + (wave >> 1), tt = wave & 1;
    const int c = it >> 3, h = it & 7;
    const float mprev = p.mprev[it];
    {
      const int t = c * 64 + lane;
      const float lfv = p.lf[t * 8 + h], igv = p.igf[t * 8 + h];
      float b = lfv;
#pragma unroll
      for (int o = 1; o < 64; o <<= 1) { float y = __shfl_up(b, o); if (lane >= o) b += y; }
      const float a = igv - b;
      float pm = a;
#pragma unroll
      for (int o = 1; o < 64; o <<= 1) { float y = __shfl_up(pm, o); if (lane >= o) pm = fmaxf(pm, y); }
      const float mt = fmaxf(b + mprev, b + pm);
      __syncthreads();
      sA[lane] = a; sA[64 + lane] = b; sA[128 + lane] = mt;
      __syncthreads();
    }
    const int tl = tt * 32 + r;
    const float b_t = sA[64 + tl], m_t = sA[128 + tl];
    const u16* qp = q_ml + (size_t)(c * 64 + tl) * 512 + h * 64 + hh * 8;
    bf16x8 qf[4];
#pragma unroll
    for (int ks = 0; ks < 4; ++ks) qf[ks] = *(const bf16x8*)(qp + ks * 16);
    f32x16 X[2];
    float den = 0.f;
#pragma unroll
    for (int st = 0; st < 2; ++st) {
#pragma unroll
      for (int i = 0; i < 16; ++i) X[st][i] = 0.f;
      if (st <= tt) {
        const u16* kp = k_ml + (size_t)(c * 64 + st * 32 + r) * 512 + h * 64 + hh * 8;
#pragma unroll
        for (int ks = 0; ks < 4; ++ks) X[st] = mfma32(*(const bf16x8*)(kp + ks * 16), qf[ks], X[st]);
#pragma unroll
        for (int i = 0; i < 16; ++i) {
          const int s = st * 32 + crow(i, hh);
          const float w = (s <= tl) ? __expf(b_t + sA[s] - m_t) : 0.f;
          X[st][i] *= w;
          den += X[st][i];
        }
      }
    }
    f32x16 acc[4];
    const u16* cp = Cb + (size_t)it * 8192 + (size_t)r * 64 + hh * 8;
#pragma unroll
    for (int mt = 0; mt < 4; ++mt) {
#pragma unroll
      for (int i = 0; i < 16; ++i) acc[mt][i] = 0.f;
#pragma unroll
      for (int ks = 0; ks < 4; ++ks) acc[mt] = mfma32(*(const bf16x8*)(cp + mt * 32 * 64 + ks * 16), qf[ks], acc[mt]);
    }
    const float s_inter = __expf(b_t + mprev - m_t);
#pragma unroll
    for (int mt = 0; mt < 4; ++mt)
#pragma unroll
      for (int i = 0; i < 16; ++i) acc[mt][i] *= s_inter;
    {
      float dq = 0.f;
      const float* np = p.nprev + it * 64 + hh * 8;
#pragma unroll
      for (int ks = 0; ks < 4; ++ks)
#pragma unroll
        for (int j = 0; j < 8; ++j) dq += bf2f((u16)qf[ks][j]) * np[ks * 16 + j];
      den += s_inter * dq;
    }
    den += __shfl_xor(den, 32);
#pragma unroll
    for (int st = 0; st < 2; ++st) {
      if (st <= tt) {
#pragma unroll
        for (int k2 = 0; k2 < 2; ++k2) {
          const bf16x8 pf = pack8(X[st][8 * k2 + 0], X[st][8 * k2 + 1], X[st][8 * k2 + 2], X[st][8 * k2 + 3],
                                  X[st][8 * k2 + 4], X[st][8 * k2 + 5], X[st][8 * k2 + 6], X[st][8 * k2 + 7]);
#pragma unroll
          for (int mt = 0; mt < 4; ++mt) {
            const u16* vp = vT + (size_t)(h * 128 + mt * 32 + r) * S + c * 64 + st * 32 + k2 * 16 + hh * 4;
            const s16x4 lo = *(const s16x4*)vp, hi = *(const s16x4*)(vp + 8);
            const bf16x8 a = __builtin_shufflevector(lo, hi, 0, 1, 2, 3, 4, 5, 6, 7);
            acc[mt] = mfma32(a, pf, acc[mt]);
          }
        }
      }
    }
    const float inv = 1.f / fmaxf(fabsf(den), __expf(-m_t));
    float sum = 0.f;
#pragma unroll
    for (int mt = 0; mt < 4; ++mt)
#pragma unroll
      for (int i = 0; i < 16; ++i) { acc[mt][i] *= inv; sum += acc[mt][i]; }
    sum += __shfl_xor(sum, 32);
    const float mean = sum * (1.f / 128.f);
    float vs = 0.f;
#pragma unroll
    for (int mt = 0; mt < 4; ++mt)
#pragma unroll
      for (int i = 0; i < 16; ++i) { const float dd = acc[mt][i] - mean; vs += dd * dd; }
    vs += __shfl_xor(vs, 32);
    const float rstd = rsqrtf(vs * (1.f / 128.f) + NORM_EPS);
    const size_t t = (size_t)c * 64 + tl;
#pragma unroll
    for (int mt = 0; mt < 4; ++mt)
#pragma unroll
      for (int g4 = 0; g4 < 4; ++g4) {
        const int col = h * 128 + mt * 32 + 8 * g4 + 4 * hh;
        const uint2 ogv = *(const uint2*)(og + t * 1024 + col);
        const float4 gv = *(const float4*)(p.a_hn_g + col);
        const float o0 = bflo(ogv.x) * (acc[mt][4 * g4 + 0] - mean) * rstd * gv.x;
        const float o1 = bfhi(ogv.x) * (acc[mt][4 * g4 + 1] - mean) * rstd * gv.y;
        const float o2 = bflo(ogv.y) * (acc[mt][4 * g4 + 2] - mean) * rstd * gv.z;
        const float o3 = bfhi(ogv.y) * (acc[mt][4 * g4 + 3] - mean) * rstd * gv.w;
        store4bf(hout + t * 1024 + col, o0, o1, o2, o3);
      }
  }
}

DI void phase_outproj(const Params& p, int layer, const u16* A, const u16* WT, const float* R, float* Y, char* smem) {
  const u16* WpT = p.WpT + (size_t)layer * 1024 * 256;
  const u16* pbl = p.pb + (size_t)layer * S * 256;
  u16* pe = p.B2;
  TILE_LOOP2(16) {
    f32x4 acc[4][8]; zero_acc2(acc);
    const int p0 = (nt_ & 7) * 128, q0 = mt_ * 256;
    if (nt_ < 8) {
      gemm_core2(WT, 1024, A, 1024, 1024, p0, q0, smem, acc);
      EPI2_BEGIN
        const float4 rv = *(const float4*)(R + (size_t)qb_ * 1024 + pb_);
        float4 o;
        o.x = DN_ALPHA * rv.x + ev_[0]; o.y = DN_ALPHA * rv.y + ev_[1];
        o.z = DN_ALPHA * rv.z + ev_[2]; o.w = DN_ALPHA * rv.w + ev_[3];
        *(float4*)(Y + (size_t)qb_ * 1024 + pb_) = o;
      EPI2_END
    } else {
      gemm_core2(WpT, 256, pbl, 256, 256, p0, q0, smem, acc);
      EPI2_BEGIN
        store4bf(pe + (size_t)qb_ * 1024 + pb_, ev_[0], ev_[1], ev_[2], ev_[3]);
      EPI2_END
    }
  }
}

DI void phase_ln(float* X, u16* Xb, const float* g, const float* bta, u8* Xq, float* sxs) {
  const int lane = TIDX & 63, wave = TIDX >> 6;
  for (int row = BIDX * 4 + wave; row < S; row += gridDim.x * 4) {
    float* xr = X + (size_t)row * 1024;
    float4 v[4];
#pragma unroll
    for (int i = 0; i < 4; ++i) v[i] = *(const float4*)(xr + i * 256 + lane * 4);
    float s = 0.f;
#pragma unroll
    for (int i = 0; i < 4; ++i) s += v[i].x + v[i].y + v[i].z + v[i].w;
    const float mean = wave_sum(s) * (1.f / 1024.f);
    float q = 0.f;
#pragma unroll
    for (int i = 0; i < 4; ++i) {
      v[i].x -= mean; v[i].y -= mean; v[i].z -= mean; v[i].w -= mean;
      q += v[i].x * v[i].x + v[i].y * v[i].y + v[i].z * v[i].z + v[i].w * v[i].w;
    }
    const float rstd = rsqrtf(wave_sum(q) * (1.f / 1024.f) + NORM_EPS);
    float amax = 0.f;
#pragma unroll
    for (int i = 0; i < 4; ++i) {
      const float4 gv = *(const float4*)(g + i * 256 + lane * 4), bv = *(const float4*)(bta + i * 256 + lane * 4);
      float4 o;
      o.x = v[i].x * rstd * gv.x + bv.x; o.y = v[i].y * rstd * gv.y + bv.y;
      o.z = v[i].z * rstd * gv.z + bv.z; o.w = v[i].w * rstd * gv.w + bv.w;
      *(float4*)(xr + i * 256 + lane * 4) = o;
      v[i] = o;
      amax = fmaxf(amax, absmax4(o));
    }
    amax = wave_max(amax);
    const float sc = amax > 0.f ? amax * (1.f / 127.f) : 1.f;
    const float inv = 1.f / sc;
#pragma unroll
    for (int i = 0; i < 4; ++i) *(unsigned*)(Xq + (size_t)row * 1024 + i * 256 + lane * 4) = q8x4(v[i], inv, 0);
    if (lane == 0) sxs[row] = sc;
  }
}

DI void phase_peer_query(const Params& p, int layer, const u16* Xb, char* smem) {
  const u16* WT = p.WpqT + (size_t)layer * 2048 * 1024;
  const u16* SK = p.SubK + (size_t)layer * 16 * 128 * 128;
  float* topk = (float*)p.B6;
  const int tid = TIDX, lane = tid & 63, wave = tid >> 6;
  TILE_LOOP(16) {
    const int slot = nt_;
    f32x4 acc[4][4];
    {
      const int p0 = slot * 128, q0 = mt_ * 128;
      i32x4_t iacc[4][4];
#pragma unroll
      for (int a = 0; a < 4; ++a)
#pragma unroll
        for (int b = 0; b < 4; ++b) iacc[a][b] = i32x4_t{0, 0, 0, 0};
      gemm_core_i8(p.Wq8 + (size_t)layer * 2048 * 1024, 1024, p.Xq8, 1024, 1024, p0, q0, smem, iacc);
      const int nb_ = p0 + (wave >> 1) * 64 + (lane >> 4) * 4, mb_ = q0 + (wave & 1) * 64 + (lane & 15);
      const float* swl = p.swq + layer * 2048;
#pragma unroll
      for (int a = 0; a < 4; ++a) {
        const float4 swv = *(const float4*)(swl + nb_ + a * 16);
#pragma unroll
        for (int b = 0; b < 4; ++b) {
          const float sxv = p.sxq[mb_ + b * 16];
          acc[a][b][0] = (float)iacc[a][b][0] * swv.x * sxv; acc[a][b][1] = (float)iacc[a][b][1] * swv.y * sxv;
          acc[a][b][2] = (float)iacc[a][b][2] * swv.z * sxv; acc[a][b][3] = (float)iacc[a][b][3] * swv.w * sxv;
        }
      }
    }
    u16* sq = (u16*)smem; u16* sk = (u16*)(smem + 128 * 136 * 2);
    {
      const int pl = (wave >> 1) * 64 + (lane >> 4) * 4, ql = (wave & 1) * 64 + (lane & 15);
#pragma unroll
      for (int a = 0; a < 4; ++a)
#pragma unroll
        for (int b = 0; b < 4; ++b)
          store4bf(sq + (ql + b * 16) * 136 + pl + a * 16, acc[a][b][0], acc[a][b][1], acc[a][b][2], acc[a][b][3]);
      const u16* skg = SK + (size_t)slot * 128 * 128;
#pragma unroll
      for (int i = 0; i < 8; ++i) {
        const int ch = tid + 256 * i, row = ch >> 4, cc = (ch & 15) * 8;
        *(uint4*)(sk + row * 136 + cc) = *(const uint4*)(skg + row * 128 + cc);
      }
    }
    __syncthreads();
    zero_acc(acc);
    {
      const int wp = wave >> 1, wq = wave & 1;
#pragma unroll
      for (int ks = 0; ks < 4; ++ks) {
        bf16x8 fa[4], fb[4];
#pragma unroll
        for (int mt = 0; mt < 4; ++mt) fa[mt] = *(const bf16x8*)(sk + (wp * 64 + mt * 16 + (lane & 15)) * 136 + ks * 32 + (lane >> 4) * 8);
#pragma unroll
        for (int nt = 0; nt < 4; ++nt) fb[nt] = *(const bf16x8*)(sq + (wq * 64 + nt * 16 + (lane & 15)) * 136 + ks * 32 + (lane >> 4) * 8);
#pragma unroll
        for (int mt = 0; mt < 4; ++mt)
#pragma unroll
          for (int nt = 0; nt < 4; ++nt) acc[mt][nt] = mfma16(fa[mt], fb[nt], acc[mt][nt]);
      }
    }
    __syncthreads();
    float* sc = (float*)smem;
    {
      const int kl = (wave >> 1) * 64 + (lane >> 4) * 4, tl = (wave & 1) * 64 + (lane & 15);
#pragma unroll
      for (int a = 0; a < 4; ++a)
#pragma unroll
        for (int b = 0; b < 4; ++b)
#pragma unroll
          for (int i = 0; i < 4; ++i) sc[(tl + b * 16) * 129 + kl + a * 16 + i] = acc[a][b][i];
    }
    __syncthreads();
    const int row = tid & 127, half = tid >> 7;
    float v[16];
#pragma unroll
    for (int i = 0; i < 16; ++i) v[i] = -INFINITY;
#pragma unroll 4
    for (int j = 0; j < 64; ++j) {
      const int key = half * 64 + j;
      const float s = sc[row * 129 + key];
      float x = __uint_as_float((__float_as_uint(s) & ~127u) | (unsigned)(127 - key));
#pragma unroll
      for (int i = 0; i < 16; ++i) { const float hi = fmaxf(v[i], x); x = fminf(v[i], x); v[i] = hi; }
    }
    __syncthreads();
    if (half) {
#pragma unroll
      for (int i = 0; i < 16; ++i) sc[row * 17 + i] = v[i];
    }
    __syncthreads();
    if (!half) {
#pragma unroll
      for (int j = 0; j < 16; ++j) {
        float x = sc[row * 17 + j];
#pragma unroll
        for (int i = 0; i < 16; ++i) { const float hi = fmaxf(v[i], x); x = fminf(v[i], x); v[i] = hi; }
      }
      float* dst = topk + ((size_t)(mt_ * 128 + row) * 16 + slot) * 16;
#pragma unroll
      for (int i = 0; i < 4; ++i) *(float4*)(dst + i * 4) = make_float4(v[4 * i], v[4 * i + 1], v[4 * i + 2], v[4 * i + 3]);
    }
  }
}

__device__ const unsigned char kCandI[64] = {
  0,0,0,0,0,0,0,0,0,0,0,0,0,0,0,0, 1,1,1,1,1,1,1,1, 2,2,2,2,2, 3,3,3,3, 4,4,4, 5,5, 6,6, 7,7, 8,9,10,11,12,13,14,15,
  0,0,0,0,0,0,0,0,0,0,0,0,0,0};
__device__ const unsigned char kCandJ[64] = {
  0,1,2,3,4,5,6,7,8,9,10,11,12,13,14,15, 0,1,2,3,4,5,6,7, 0,1,2,3,4, 0,1,2,3, 0,1,2, 0,1, 0,1, 0,1, 0,0,0,0,0,0,0,0,
  0,0,0,0,0,0,0,0,0,0,0,0,0,0};

DI void phase_peer_gather(const Params& p, int layer, const float* Xin, float* Xout, u16* Xoutb, const float* lng,
                          const float* lnb, char* smem) {
  const int tid = TIDX, lane = tid & 63, wave = tid >> 6;
  char* wsm = smem + wave * 3072;
  float* stk = (float*)wsm; int* sidx = (int*)(wsm + 1024); float* swt = (float*)(wsm + 1536); float* sact = (float*)(wsm + 2048);
  const u8* U = p.Uq + (size_t)layer * 16384 * 1024;
  const u8* V = p.Vq + (size_t)layer * 16384 * 1024;
  const float* scU = p.scU + layer * 16384;
  const float* scV = p.scV + layer * 16384;
  const float* topk = (const float*)p.B6;
  const int ci = kCandI[lane], cj = kCandJ[lane];
  float4 nx0, nx1, nx2, nx3, ntk;
  {
    const int tok0 = BIDX * 4 + wave;
    const float* xr = Xin + (size_t)tok0 * 1024 + lane * 16;
    nx0 = *(const float4*)xr; nx1 = *(const float4*)(xr + 4); nx2 = *(const float4*)(xr + 8); nx3 = *(const float4*)(xr + 12);
    ntk = *(const float4*)(topk + (size_t)tok0 * 256 + lane * 4);
  }
  for (int bi = BIDX; bi < S / 4; bi += gridDim.x) {
    const int tok = bi * 4 + wave;
    const float4 x0 = nx0, x1 = nx1, x2 = nx2, x3 = nx3, tkv = ntk;
    {
      const int bn = (bi + (int)gridDim.x < S / 4) ? bi + (int)gridDim.x : bi;
      const int tokn = bn * 4 + wave;
      const float* xr = Xin + (size_t)tokn * 1024 + lane * 16;
      nx0 = *(const float4*)xr; nx1 = *(const float4*)(xr + 4); nx2 = *(const float4*)(xr + 8); nx3 = *(const float4*)(xr + 12);
      ntk = *(const float4*)(topk + (size_t)tokn * 256 + lane * 4);
    }
    float mxa = fmaxf(fmaxf(absmax4(x0), absmax4(x1)), fmaxf(absmax4(x2), absmax4(x3)));
    mxa = wave_max(mxa);
    const float sx = mxa > 0.f ? mxa * (1.f / 127.f) : 1.f;
    const float sxi = 1.f / sx;
    __builtin_amdgcn_fence(__ATOMIC_ACQ_REL, "wavefront");
    *(float4*)(stk + lane * 4) = tkv;
#pragma unroll 1
    for (int h = 0; h < 8; ++h) {
      const unsigned ua = __float_as_uint(stk[(h * 2) * 16 + ci]);
      const unsigned ub = __float_as_uint(stk[(h * 2 + 1) * 16 + cj]);
      const float val = (lane < 50) ? __uint_as_float(ua & ~127u) + __uint_as_float(ub & ~127u) : -3.0e38f;
      const int eidx = (127 - (int)(ua & 127u)) * 128 + (127 - (int)(ub & 127u));
      const float key = __uint_as_float((__float_as_uint(val) & ~63u) | (unsigned)(63 - lane));
      const int kbits = (int)__float_as_uint(key);
      int cnt = 0;
#pragma unroll 10
      for (int j = 0; j < 50; ++j) {
        const float vj = __uint_as_float((unsigned)__builtin_amdgcn_readlane(kbits, j));
        cnt += (vj > key) ? 1 : 0;
      }
      const float mx = __uint_as_float((unsigned)__builtin_amdgcn_readlane((int)__float_as_uint(val), 0));
      const float e = (cnt < 16) ? __expf(val - mx) : 0.f;
      const float sum = wave_sum(e);
      if (cnt < 16) { sidx[h * 16 + cnt] = eidx; swt[h * 16 + cnt] = e / sum; }
    }
    __builtin_amdgcn_fence(__ATOMIC_ACQ_REL, "wavefront");
    {
      const int xq0 = (int)q8x4(x0, sxi, 0), xq1 = (int)q8x4(x1, sxi, 0), xq2 = (int)q8x4(x2, sxi, 0), xq3 = (int)q8x4(x3, sxi, 0);
      const bool b5 = (lane & 32) != 0, b4 = (lane & 16) != 0, b3 = (lane & 8) != 0;
      const int eslot = (b5 ? 4 : 0) + (b4 ? 2 : 0) + (b3 ? 1 : 0);
#pragma unroll 2
      for (int e0 = 0; e0 < 128; e0 += 8) {
        i32x4 a[8];
#pragma unroll
        for (int j2 = 0; j2 < 8; ++j2) {
          const int ei = __builtin_amdgcn_readfirstlane(sidx[e0 + j2]);
          a[j2] = *(const i32x4*)(U + (size_t)ei * 1024 + lane * 16);
        }
        int pp[8];
#pragma unroll
        for (int j2 = 0; j2 < 8; ++j2) {
          int c = __builtin_amdgcn_sdot4(a[j2][0], xq0, 0, false);
          c = __builtin_amdgcn_sdot4(a[j2][1], xq1, c, false);
          c = __builtin_amdgcn_sdot4(a[j2][2], xq2, c, false);
          pp[j2] = __builtin_amdgcn_sdot4(a[j2][3], xq3, c, false);
        }
        int qq[4];
#pragma unroll
        for (int j2 = 0; j2 < 4; ++j2) {
          const int snd = b5 ? pp[j2] : pp[j2 + 4];
          const int keep = b5 ? pp[j2 + 4] : pp[j2];
          qq[j2] = keep + __shfl_xor(snd, 32);
        }
        int rr[2];
#pragma unroll
        for (int j2 = 0; j2 < 2; ++j2) {
          const int snd = b4 ? qq[j2] : qq[j2 + 2];
          const int keep = b4 ? qq[j2 + 2] : qq[j2];
          rr[j2] = keep + __shfl_xor(snd, 16);
        }
        int ss;
        {
          const int snd = b3 ? rr[0] : rr[1];
          const int keep = b3 ? rr[1] : rr[0];
          ss = keep + __shfl_xor(snd, 8);
        }
        ss += __shfl_xor(ss, 4);
        ss += __shfl_xor(ss, 2);
        ss += __shfl_xor(ss, 1);
        if ((lane & 7) == 0) sact[e0 + eslot] = (float)ss;
      }
    }
    __builtin_amdgcn_fence(__ATOMIC_ACQ_REL, "wavefront");
    float scw;
    {
      float wv[2];
#pragma unroll
      for (int q2 = 0; q2 < 2; ++q2) {
        const int e = lane + 64 * q2;
        const int idx = sidx[e];
        const float a = sact[e] * sx * scU[idx];
        wv[q2] = swt[e] * 0.5f * a * (1.f + erff(a * 0.70710678118654752f)) * scV[idx];
      }
      const float wm = wave_max(fmaxf(fabsf(wv[0]), fabsf(wv[1])));
      scw = wm > 0.f ? wm * (1.f / 127.f) : 1.f;
      const float winv = 1.f / scw;
      u8* sw8 = (u8*)swt;
      __builtin_amdgcn_fence(__ATOMIC_ACQ_REL, "wavefront");
      sw8[lane] = (u8)q8(wv[0], winv, 0);
      sw8[lane + 64] = (u8)q8(wv[1], winv, 0);
    }
    __builtin_amdgcn_fence(__ATOMIC_ACQ_REL, "wavefront");
    int oi[16];
#pragma unroll
    for (int i = 0; i < 16; ++i) oi[i] = 0;
    const unsigned* sw32 = (const unsigned*)swt;
#pragma unroll 1
    for (int e0 = 0; e0 < 128; e0 += 8) {
      u32x4 bb[8];
#pragma unroll
      for (int j = 0; j < 8; ++j) {
        const int ei = __builtin_amdgcn_readfirstlane(sidx[e0 + j]);
        bb[j] = *(const u32x4*)(V + (size_t)ei * 1024 + lane * 16);
      }
#pragma unroll
      for (int g = 0; g < 2; ++g) {
        const int w4 = (int)sw32[(e0 >> 2) + g];
#pragma unroll
        for (int d = 0; d < 4; ++d) {
          const unsigned r0 = bb[4 * g][d], r1 = bb[4 * g + 1][d], r2 = bb[4 * g + 2][d], r3 = bb[4 * g + 3][d];
          const unsigned ta = __builtin_amdgcn_perm(r1, r0, 0x05010400u);
          const unsigned tb = __builtin_amdgcn_perm(r3, r2, 0x05010400u);
          const unsigned tc = __builtin_amdgcn_perm(r1, r0, 0x07030602u);
          const unsigned td = __builtin_amdgcn_perm(r3, r2, 0x07030602u);
          const unsigned c0 = __builtin_amdgcn_perm(tb, ta, 0x05040100u);
          const unsigned c1 = __builtin_amdgcn_perm(tb, ta, 0x07060302u);
          const unsigned c2 = __builtin_amdgcn_perm(td, tc, 0x05040100u);
          const unsigned c3 = __builtin_amdgcn_perm(td, tc, 0x07060302u);
          oi[4 * d + 0] = __builtin_amdgcn_sdot4((int)c0, w4, oi[4 * d + 0], false);
          oi[4 * d + 1] = __builtin_amdgcn_sdot4((int)c1, w4, oi[4 * d + 1], false);
          oi[4 * d + 2] = __builtin_amdgcn_sdot4((int)c2, w4, oi[4 * d + 2], false);
          oi[4 * d + 3] = __builtin_amdgcn_sdot4((int)c3, w4, oi[4 * d + 3], false);
        }
      }
    }
    const float corr = 0.f;
    float o[16];
#pragma unroll
    for (int i = 0; i < 16; ++i) o[i] = (float)oi[i] * scw;
    float y[16];
    y[0] = DN_ALPHA * x0.x + o[0] - corr; y[1] = DN_ALPHA * x0.y + o[1] - corr; y[2] = DN_ALPHA * x0.z + o[2] - corr; y[3] = DN_ALPHA * x0.w + o[3] - corr;
    y[4] = DN_ALPHA * x1.x + o[4] - corr; y[5] = DN_ALPHA * x1.y + o[5] - corr; y[6] = DN_ALPHA * x1.z + o[6] - corr; y[7] = DN_ALPHA * x1.w + o[7] - corr;
    y[8] = DN_ALPHA * x2.x + o[8] - corr; y[9] = DN_ALPHA * x2.y + o[9] - corr; y[10] = DN_ALPHA * x2.z + o[10] - corr; y[11] = DN_ALPHA * x2.w + o[11] - corr;
    y[12] = DN_ALPHA * x3.x + o[12] - corr; y[13] = DN_ALPHA * x3.y + o[13] - corr; y[14] = DN_ALPHA * x3.z + o[14] - corr; y[15] = DN_ALPHA * x3.w + o[15] - corr;
    float s_ = 0.f;
#pragma unroll
    for (int i = 0; i < 16; ++i) s_ += y[i];
    const float mean = wave_sum(s_) * (1.f / 1024.f);
    float q = 0.f;
#pragma unroll
    for (int i = 0; i < 16; ++i) { y[i] -= mean; q += y[i] * y[i]; }
    const float rstd = rsqrtf(wave_sum(q) * (1.f / 1024.f) + NORM_EPS);
    const int col = lane * 16;
    float r_[16];
#pragma unroll
    for (int i = 0; i < 16; ++i) r_[i] = y[i] * rstd * lng[col + i] + lnb[col + i];
    float* xo = Xout + (size_t)tok * 1024 + col;
#pragma unroll
    for (int i = 0; i < 4; ++i) *(float4*)(xo + 4 * i) = make_float4(r_[4 * i], r_[4 * i + 1], r_[4 * i + 2], r_[4 * i + 3]);
    {
      float am = 0.f;
#pragma unroll
      for (int i = 0; i < 16; ++i) am = fmaxf(am, fabsf(r_[i]));
      am = wave_max(am);
      const float sc = am > 0.f ? am * (1.f / 127.f) : 1.f;
      const float inv = 1.f / sc;
      u32x4 o8;
#pragma unroll
      for (int k = 0; k < 4; ++k) o8[k] = q8(r_[4 * k], inv, 0) | (q8(r_[4 * k + 1], inv, 0) << 8) | (q8(r_[4 * k + 2], inv, 0) << 16) | (q8(r_[4 * k + 3], inv, 0) << 24);
      *(u32x4*)(p.Xq8 + (size_t)tok * 1024 + col) = o8;
      if (lane == 0) p.sxq[tok] = sc;
    }
  }
}

DI void phase_peer_u(const Params& p, int layer, const float* Xin, char* smem) {
  const int tid = TIDX, lane = tid & 63, wave = tid >> 6;
  char* wsm = smem + wave * 13312;
  u8* sxq = (u8*)wsm;
  int* sidx = (int*)(wsm + 4096);
  float* sgate = (float*)(wsm + 6144);
  float* sact = (float*)(wsm + 8192);
  unsigned* slist = (unsigned*)(wsm + 10240);
  float* stk = (float*)(wsm + 12288);
  const u8* U = p.Uq + (size_t)layer * 16384 * 1024;
  const float* scU = p.scU + layer * 16384;
  const float* scV = p.scV + layer * 16384;
  float* topk = (float*)p.B6;
  const int ci = kCandI[lane], cj = kCandJ[lane];
  const int ntw = (S / 4) / (int)gridDim.x;
  for (int g0 = 0; g0 < ntw; g0 += 4) {
    float sxr[4];
    unsigned ent[8];
#pragma unroll
    for (int k = 0; k < 4; ++k) {
      const int tok = (BIDX + (g0 + k) * (int)gridDim.x) * 4 + wave;
      const float* xr = Xin + (size_t)tok * 1024 + lane * 16;
      const float4 x0 = *(const float4*)xr, x1 = *(const float4*)(xr + 4), x2 = *(const float4*)(xr + 8), x3 = *(const float4*)(xr + 12);
      const float4 tkv = *(const float4*)(topk + (size_t)tok * 256 + lane * 4);
      float mxa = fmaxf(fmaxf(absmax4(x0), absmax4(x1)), fmaxf(absmax4(x2), absmax4(x3)));
      mxa = wave_max(mxa);
      const float sx = mxa > 0.f ? mxa * (1.f / 127.f) : 1.f;
      const float sxi = 1.f / sx;
      sxr[k] = sx;
      {
        u32x4 o; o[0] = q8x4(x0, sxi, 0); o[1] = q8x4(x1, sxi, 0); o[2] = q8x4(x2, sxi, 0); o[3] = q8x4(x3, sxi, 0);
        *(u32x4*)(sxq + k * 1024 + lane * 16) = o;
      }
      __builtin_amdgcn_fence(__ATOMIC_ACQ_REL, "wavefront");
      *(float4*)(stk + lane * 4) = tkv;
      __builtin_amdgcn_fence(__ATOMIC_ACQ_REL, "wavefront");
#pragma unroll 1
      for (int h = 0; h < 8; ++h) {
        const unsigned ua = __float_as_uint(stk[(h * 2) * 16 + ci]);
        const unsigned ub = __float_as_uint(stk[(h * 2 + 1) * 16 + cj]);
        const float val = (lane < 50) ? __uint_as_float(ua & ~127u) + __uint_as_float(ub & ~127u) : -3.0e38f;
        const int eidx = (127 - (int)(ua & 127u)) * 128 + (127 - (int)(ub & 127u));
        const float key = __uint_as_float((__float_as_uint(val) & ~63u) | (unsigned)(63 - lane));
        const int kbits = (int)__float_as_uint(key);
        int cnt = 0;
#pragma unroll 10
        for (int j = 0; j < 50; ++j) {
          const float vj = __uint_as_float((unsigned)__builtin_amdgcn_readlane(kbits, j));
          cnt += (vj > key) ? 1 : 0;
        }
        const float mx = __uint_as_float((unsigned)__builtin_amdgcn_readlane((int)__float_as_uint(val), 0));
        const float e = (cnt < 16) ? __expf(val - mx) : 0.f;
        const float sum = wave_sum(e);
        if (cnt < 16) { sidx[k * 128 + h * 16 + cnt] = eidx; sgate[k * 128 + h * 16 + cnt] = e / sum; }
      }
      __builtin_amdgcn_fence(__ATOMIC_ACQ_REL, "wavefront");
      ent[2 * k] = (unsigned)sidx[k * 128 + lane] | ((unsigned)k << 14) | ((unsigned)lane << 17);
      ent[2 * k + 1] = (unsigned)sidx[k * 128 + lane + 64] | ((unsigned)k << 14) | ((unsigned)(lane + 64) << 17);
    }
    {
      int base = 0;
#pragma unroll 1
      for (int r = 0; r < 8; ++r) {
#pragma unroll
        for (int q2 = 0; q2 < 8; ++q2) {
          const bool mine = ((int)((ent[q2] & 0x3fffu) >> 11) ^ (((g0 >> 2) & 1) ? 7 : 0)) == r;
          const unsigned long long m = __builtin_amdgcn_ballot_w64(mine);
          if (mine) slist[base + (int)__builtin_amdgcn_mbcnt_hi((unsigned)(m >> 32), __builtin_amdgcn_mbcnt_lo((unsigned)m, 0u))] = ent[q2];
          base += __builtin_popcountll(m);
        }
      }
    }
    __builtin_amdgcn_fence(__ATOMIC_ACQ_REL, "wavefront");
    {
      const bool b5 = (lane & 32) != 0, b4 = (lane & 16) != 0, b3 = (lane & 8) != 0;
      const int eslot = (b5 ? 4 : 0) + (b4 ? 2 : 0) + (b3 ? 1 : 0);
      unsigned evn = slist[lane & 7];
#pragma unroll 2
      for (int c = 0; c < 64; ++c) {
        i32x4 a[8], xq[8];
        int adr[8];
        const int ev = (int)evn;
        evn = slist[((c + 1 < 64) ? c + 1 : c) * 8 + (lane & 7)];
#pragma unroll
        for (int j2 = 0; j2 < 8; ++j2) {
          const unsigned en = (unsigned)__builtin_amdgcn_readlane(ev, j2);
          const int ei = (int)(en & 0x3fffu), kk = (int)((en >> 14) & 7u);
          adr[j2] = kk * 128 + (int)(en >> 17);
          a[j2] = *(const i32x4*)(U + (size_t)ei * 1024 + lane * 16);
          xq[j2] = *(const i32x4*)(sxq + kk * 1024 + lane * 16);
        }
        int pp[8];
#pragma unroll
        for (int j2 = 0; j2 < 8; ++j2) {
          int cc = __builtin_amdgcn_sdot4(a[j2][0], xq[j2][0], 0, false);
          cc = __builtin_amdgcn_sdot4(a[j2][1], xq[j2][1], cc, false);
          cc = __builtin_amdgcn_sdot4(a[j2][2], xq[j2][2], cc, false);
          pp[j2] = __builtin_amdgcn_sdot4(a[j2][3], xq[j2][3], cc, false);
        }
        int qq[4];
#pragma unroll
        for (int j2 = 0; j2 < 4; ++j2) {
          const auto sw = __builtin_amdgcn_permlane32_swap((unsigned)pp[j2], (unsigned)pp[j2 + 4], false, false);
          qq[j2] = (int)sw[0] + (int)sw[1];
        }
        int rr[2];
#pragma unroll
        for (int j2 = 0; j2 < 2; ++j2) {
          const auto sw = __builtin_amdgcn_permlane16_swap((unsigned)qq[j2], (unsigned)qq[j2 + 2], false, false);
          rr[j2] = (int)sw[0] + (int)sw[1];
        }
        int ss;
        {
          const int snd = b3 ? rr[0] : rr[1];
          const int keep = b3 ? rr[1] : rr[0];
          ss = keep + __builtin_amdgcn_update_dpp(0, snd, 0x140, 0xf, 0xf, true);
        }
        ss += __builtin_amdgcn_update_dpp(0, ss, 0xB1, 0xf, 0xf, true);
        ss += __builtin_amdgcn_update_dpp(0, ss, 0x4E, 0xf, 0xf, true);
        ss += __builtin_amdgcn_update_dpp(0, ss, 0x141, 0xf, 0xf, true);
        int ad = adr[0];
#pragma unroll
        for (int j2 = 1; j2 < 8; ++j2) ad = (eslot == j2) ? adr[j2] : ad;
        if ((lane & 7) == 0) sact[ad] = (float)ss;
      }
    }
    __builtin_amdgcn_fence(__ATOMIC_ACQ_REL, "wavefront");
#pragma unroll
    for (int k = 0; k < 4; ++k) {
      const int tok = (BIDX + (g0 + k) * (int)gridDim.x) * 4 + wave;
      int* gl = (int*)(topk + (size_t)tok * 256);
#pragma unroll
      for (int q2 = 0; q2 < 2; ++q2) {
        const int e = lane + 64 * q2;
        const int idx = sidx[k * 128 + e];
        const float a = sact[k * 128 + e] * sxr[k] * scU[idx];
        gl[e] = idx;
        ((float*)gl)[128 + e] = sgate[k * 128 + e] * 0.5f * a * (1.f + erff(a * 0.70710678118654752f)) * scV[idx];
      }
    }
    __builtin_amdgcn_fence(__ATOMIC_ACQ_REL, "wavefront");
  }
}

DI void phase_peer_v(const Params& p, int layer, const float* Xin, float* Xout, const float* lng, const float* lnb, char* smem) {
  const int tid = TIDX, lane = tid & 63, wave = tid >> 6;
  char* wsm = smem + wave * 2048;
  int* sidx = (int*)wsm; float* swt = (float*)(wsm + 512); int* sraw = (int*)(wsm + 1024);
  const u8* V = p.Vq + (size_t)layer * 16384 * 1024;
  const float* lists = (const float*)p.B6;
  float4 nx0, nx1, nx2, nx3, nlv;
  {
    const int tok0 = BIDX * 4 + wave;
    const float* xr = Xin + (size_t)tok0 * 1024 + lane * 16;
    nx0 = *(const float4*)xr; nx1 = *(const float4*)(xr + 4); nx2 = *(const float4*)(xr + 8); nx3 = *(const float4*)(xr + 12);
    nlv = *(const float4*)(lists + (size_t)tok0 * 256 + lane * 4);
  }
  for (int bi = BIDX; bi < S / 4; bi += gridDim.x) {
    const int tok = bi * 4 + wave;
    const float4 x0 = nx0, x1 = nx1, x2 = nx2, x3 = nx3, lv = nlv;
    {
      const int bn = (bi + (int)gridDim.x < S / 4) ? bi + (int)gridDim.x : bi;
      const int tokn = bn * 4 + wave;
      const float* xr = Xin + (size_t)tokn * 1024 + lane * 16;
      nx0 = *(const float4*)xr; nx1 = *(const float4*)(xr + 4); nx2 = *(const float4*)(xr + 8); nx3 = *(const float4*)(xr + 12);
      nlv = *(const float4*)(lists + (size_t)tokn * 256 + lane * 4);
    }
    __builtin_amdgcn_fence(__ATOMIC_ACQ_REL, "wavefront");
    *(float4*)((float*)sraw + lane * 4) = lv;
    __builtin_amdgcn_fence(__ATOMIC_ACQ_REL, "wavefront");
    float scw;
    {
      const int i0 = sraw[lane], i1 = sraw[lane + 64];
      const float w0 = __int_as_float(sraw[128 + lane]), w1 = __int_as_float(sraw[128 + lane + 64]);
      const float wm = wave_max(fmaxf(fabsf(w0), fabsf(w1)));
      scw = wm > 0.f ? wm * (1.f / 127.f) : 1.f;
      const float winv = 1.f / scw;
      const unsigned q0 = q8(w0, winv, 0), q1 = q8(w1, winv, 0);
      u8* sw8 = (u8*)swt;
      const int flip = (((bi - BIDX) / (int)gridDim.x) & 1) ? 7 : 0;
      const int r0 = (i0 >> 11) ^ flip, r1 = (i1 >> 11) ^ flip;
      int base = 0;
#pragma unroll 1
      for (int r = 0; r < 8; ++r) {
        const unsigned long long m0 = __builtin_amdgcn_ballot_w64(r0 == r);
        const unsigned long long m1 = __builtin_amdgcn_ballot_w64(r1 == r);
        const int c0 = __builtin_popcountll(m0);
        if (r0 == r) {
          const int pos = base + (int)__builtin_amdgcn_mbcnt_hi((unsigned)(m0 >> 32), __builtin_amdgcn_mbcnt_lo((unsigned)m0, 0u));
          sidx[pos] = i0; sw8[pos] = (u8)q0;
        }
        if (r1 == r) {
          const int pos = base + c0 + (int)__builtin_amdgcn_mbcnt_hi((unsigned)(m1 >> 32), __builtin_amdgcn_mbcnt_lo((unsigned)m1, 0u));
          sidx[pos] = i1; sw8[pos] = (u8)q1;
        }
        base += c0 + __builtin_popcountll(m1);
      }
    }
    __builtin_amdgcn_fence(__ATOMIC_ACQ_REL, "wavefront");
    int oi[16];
#pragma unroll
    for (int i = 0; i < 16; ++i) oi[i] = 0;
    const unsigned* sw32 = (const unsigned*)swt;
    int ivn = sidx[lane & 7];
#pragma unroll 1
    for (int e0 = 0; e0 < 128; e0 += 8) {
      u32x4 bb[8];
      const int iv = ivn;
      ivn = sidx[((e0 + 8 < 128) ? e0 + 8 : e0) + (lane & 7)];
#pragma unroll
      for (int j = 0; j < 8; ++j) {
        const int ei = __builtin_amdgcn_readlane(iv, j);
        bb[j] = *(const u32x4*)(V + (size_t)ei * 1024 + lane * 16);
      }
#pragma unroll
      for (int g = 0; g < 2; ++g) {
        const int w4 = (int)sw32[(e0 >> 2) + g];
#pragma unroll
        for (int d = 0; d < 4; ++d) {
          const unsigned r0 = bb[4 * g][d], r1 = bb[4 * g + 1][d], r2 = bb[4 * g + 2][d], r3 = bb[4 * g + 3][d];
          const unsigned ta = __builtin_amdgcn_perm(r1, r0, 0x05010400u);
          const unsigned tb = __builtin_amdgcn_perm(r3, r2, 0x05010400u);
          const unsigned tc = __builtin_amdgcn_perm(r1, r0, 0x07030602u);
          const unsigned td = __builtin_amdgcn_perm(r3, r2, 0x07030602u);
          const unsigned c0 = __builtin_amdgcn_perm(tb, ta, 0x05040100u);
          const unsigned c1 = __builtin_amdgcn_perm(tb, ta, 0x07060302u);
          const unsigned c2 = __builtin_amdgcn_perm(td, tc, 0x05040100u);
          const unsigned c3 = __builtin_amdgcn_perm(td, tc, 0x07060302u);
          oi[4 * d + 0] = __builtin_amdgcn_sdot4((int)c0, w4, oi[4 * d + 0], false);
          oi[4 * d + 1] = __builtin_amdgcn_sdot4((int)c1, w4, oi[4 * d + 1], false);
          oi[4 * d + 2] = __builtin_amdgcn_sdot4((int)c2, w4, oi[4 * d + 2], false);
          oi[4 * d + 3] = __builtin_amdgcn_sdot4((int)c3, w4, oi[4 * d + 3], false);
        }
      }
    }
    const float corr = 0.f;
    float o[16];
#pragma unroll
    for (int i = 0; i < 16; ++i) o[i] = (float)oi[i] * scw;
    float y[16];
    y[0] = DN_ALPHA * x0.x + o[0] - corr; y[1] = DN_ALPHA * x0.y + o[1] - corr; y[2] = DN_ALPHA * x0.z + o[2] - corr; y[3] = DN_ALPHA * x0.w + o[3] - corr;
    y[4] = DN_ALPHA * x1.x + o[4] - corr; y[5] = DN_ALPHA * x1.y + o[5] - corr; y[6] = DN_ALPHA * x1.z + o[6] - corr; y[7] = DN_ALPHA * x1.w + o[7] - corr;
    y[8] = DN_ALPHA * x2.x + o[8] - corr; y[9] = DN_ALPHA * x2.y + o[9] - corr; y[10] = DN_ALPHA * x2.z + o[10] - corr; y[11] = DN_ALPHA * x2.w + o[11] - corr;
    y[12] = DN_ALPHA * x3.x + o[12] - corr; y[13] = DN_ALPHA * x3.y + o[13] - corr; y[14] = DN_ALPHA * x3.z + o[14] - corr; y[15] = DN_ALPHA * x3.w + o[15] - corr;
    float s_ = 0.f;
#pragma unroll
    for (int i = 0; i < 16; ++i) s_ += y[i];
    const float mean = wave_sum(s_) * (1.f / 1024.f);
    float q = 0.f;
#pragma unroll
    for (int i = 0; i < 16; ++i) { y[i] -= mean; q += y[i] * y[i]; }
    const float rstd = rsqrtf(wave_sum(q) * (1.f / 1024.f) + NORM_EPS);
    const int col = lane * 16;
    float r_[16];
#pragma unroll
    for (int i = 0; i < 16; ++i) r_[i] = y[i] * rstd * lng[col + i] + lnb[col + i];
    float* xo = Xout + (size_t)tok * 1024 + col;
#pragma unroll
    for (int i = 0; i < 4; ++i) *(float4*)(xo + 4 * i) = make_float4(r_[4 * i], r_[4 * i + 1], r_[4 * i + 2], r_[4 * i + 3]);
    {
      float am = 0.f;
#pragma unroll
      for (int i = 0; i < 16; ++i) am = fmaxf(am, fabsf(r_[i]));
      am = wave_max(am);
      const float sc = am > 0.f ? am * (1.f / 127.f) : 1.f;
      const float inv = 1.f / sc;
      u32x4 o8;
#pragma unroll
      for (int k = 0; k < 4; ++k) o8[k] = q8(r_[4 * k], inv, 0) | (q8(r_[4 * k + 1], inv, 0) << 8) | (q8(r_[4 * k + 2], inv, 0) << 16) | (q8(r_[4 * k + 3], inv, 0) << 24);
      *(u32x4*)(p.Xq8 + (size_t)tok * 1024 + col) = o8;
      if (lane == 0) p.sxq[tok] = sc;
    }
  }
}

DI void phase_ple(const Params& p, int layer, const float* X, const u16* Xb, float* Xout, u16* Xoutb, char* smem) {
  const u8* Wg8 = p.Wg8 + (size_t)layer * 1024 * 1024;
  const float* swl = p.swg + layer * 1024;
  const u16* pe = p.B2;
  TILE_LOOP(8) {
    const int p0 = nt_ * 128, q0 = mt_ * 128;
    f32x4 acc[4][4];
    {
      i32x4_t iacc[4][4];
#pragma unroll
      for (int a = 0; a < 4; ++a)
#pragma unroll
        for (int b = 0; b < 4; ++b) iacc[a][b] = i32x4_t{0, 0, 0, 0};
      gemm_core_i8(Wg8, 1024, p.Xq8, 1024, 1024, p0, q0, smem, iacc);
      const int lane = TIDX & 63, wave = TIDX >> 6;
      const int nb_ = p0 + (wave >> 1) * 64 + (lane >> 4) * 4, mb_ = q0 + (wave & 1) * 64 + (lane & 15);
#pragma unroll
      for (int a = 0; a < 4; ++a) {
        const float4 swv = *(const float4*)(swl + nb_ + a * 16);
#pragma unroll
        for (int b = 0; b < 4; ++b) {
          const float sxv = p.sxq[mb_ + b * 16];
          acc[a][b][0] = (float)iacc[a][b][0] * swv.x * sxv; acc[a][b][1] = (float)iacc[a][b][1] * swv.y * sxv;
          acc[a][b][2] = (float)iacc[a][b][2] * swv.z * sxv; acc[a][b][3] = (float)iacc[a][b][3] * swv.w * sxv;
        }
      }
    }
    EPI_BEGIN
      const size_t o_ = (size_t)qb_ * 1024 + pb_;
      const float4 xv = *(const float4*)(X + o_);
      const uint2 pv = *(const uint2*)(pe + o_);
      float4 o;
      o.x = xv.x + sigmoidf_(ev_[0]) * bflo(pv.x); o.y = xv.y + sigmoidf_(ev_[1]) * bfhi(pv.x);
      o.z = xv.z + sigmoidf_(ev_[2]) * bflo(pv.y); o.w = xv.w + sigmoidf_(ev_[3]) * bfhi(pv.y);
      { f32x4 ov = {o.x, o.y, o.z, o.w}; __builtin_nontemporal_store(ov, (f32x4*)(Xout + o_)); }
      if (Xoutb) store4bf(Xoutb + o_, o.x, o.y, o.z, o.w);
    EPI_END
  }
}

DI void phase_mla_down(const Params& p, const u16* Xb, float* ckr, char* smem) {
  TILE_LOOP(6) {
    const int p0 = nt_ * 128, q0 = mt_ * 128;
    f32x4 acc[4][4]; zero_acc(acc);
    gemm_core(p.WdT, 1024, Xb, 1024, 1024, p0, q0, smem, acc);
    EPI_BEGIN
      *(f32x4*)(ckr + (size_t)qb_ * 768 + pb_) = ev_;
    EPI_END
  }
}
DI void phase_mla_norm(const Params& p, const float* ckr) {
  const int lane = TIDX & 63, wave = TIDX >> 6;
  for (int row = BIDX * 4 + wave; row < S; row += gridDim.x * 4) {
    const float* cr = ckr + (size_t)row * 768;
    const float4 a = *(const float4*)(cr + lane * 4);
    const float2 b0 = *(const float2*)(cr + 256 + lane * 6), b1 = *(const float2*)(cr + 256 + lane * 6 + 2), b2 = *(const float2*)(cr + 256 + lane * 6 + 4);
    const float kr = cr[640 + lane];
    const float ra = rsqrtf(wave_sum(a.x * a.x + a.y * a.y + a.z * a.z + a.w * a.w) * (1.f / 256.f) + NORM_EPS);
    const float rb = rsqrtf(wave_sum(b0.x * b0.x + b0.y * b0.y + b1.x * b1.x + b1.y * b1.y + b2.x * b2.x + b2.y * b2.y) * (1.f / 384.f) + NORM_EPS);
    store4bf(p.ckvb + (size_t)row * 256 + lane * 4, a.x * ra, a.y * ra, a.z * ra, a.w * ra);
    unsigned* cq = (unsigned*)(p.cqb + (size_t)row * 384 + lane * 6);
    cq[0] = pack2(b0.x * rb, b0.y * rb); cq[1] = pack2(b1.x * rb, b1.y * rb); cq[2] = pack2(b2.x * rb, b2.y * rb);
    const float other = __shfl_xor(kr, 32);
    const int f = lane & 31;
    const float cs = p.ropec[row * 32 + f], sn = p.ropes[row * 32 + f];
    const float o = (lane < 32) ? (kr * cs - other * sn) : (other * sn + kr * cs);
    p.krope[(size_t)row * 64 + lane] = f2bf(o);
  }
}

DI void phase_mla_up(const Params& p, char* smem) {
  u16* knope = p.B2; u16* vTa = p.B3; u16* qatt = p.B0;
  TILE_LOOP(28) {
    f32x4 acc[4][4]; zero_acc(acc);
    if (nt_ < 16) {
      const int hd = nt_ >> 1;
      if (nt_ & 1) {
        const int p0 = mt_ * 128, q0 = nt_ * 128;
        gemm_core(p.ckvb, 256, p.WupT, 256, 256, p0, q0, smem, acc);
        EPI_BEGIN
          store4bf(vTa + (size_t)(hd * 128 + qb_ - q0) * S + pb_, ev_[0], ev_[1], ev_[2], ev_[3]);
        EPI_END
      } else {
        const int p0 = nt_ * 128, q0 = mt_ * 128;
        gemm_core(p.WupT, 256, p.ckvb, 256, 256, p0, q0, smem, acc);
        EPI_BEGIN
          store4bf(knope + (size_t)qb_ * 1024 + hd * 128 + pb_ - p0, ev_[0], ev_[1], ev_[2], ev_[3]);
        EPI_END
      }
    } else {
      const int p0 = (nt_ - 16) * 128, q0 = mt_ * 128;
      gemm_core(p.WuqT, 384, p.cqb, 384, 384, p0, q0, smem, acc);
      EPI_BEGIN
        const int grp = pb_ >> 6;
        const int w_ = pb_ & 63;
        if ((grp % 3) == 2) {
          if (w_ < 32) {
            const f32x4 x2 = *(const f32x4*)((const float*)smem + er_ * 132 + ec_ + 32);
            const float4 cs = *(const float4*)(p.ropec + (size_t)qb_ * 32 + w_), sn = *(const float4*)(p.ropes + (size_t)qb_ * 32 + w_);
            store4bf(qatt + (size_t)qb_ * 1536 + pb_, ev_[0] * cs.x - x2[0] * sn.x, ev_[1] * cs.y - x2[1] * sn.y,
                     ev_[2] * cs.z - x2[2] * sn.z, ev_[3] * cs.w - x2[3] * sn.w);
            store4bf(qatt + (size_t)qb_ * 1536 + pb_ + 32, ev_[0] * sn.x + x2[0] * cs.x, ev_[1] * sn.y + x2[1] * cs.y,
                     ev_[2] * sn.z + x2[2] * cs.z, ev_[3] * sn.w + x2[3] * cs.w);
          }
        } else {
          store4bf(qatt + (size_t)qb_ * 1536 + pb_, ev_[0], ev_[1], ev_[2], ev_[3]);
        }
      EPI_END
    }
  }
}

DI void phase_attn(const Params& p, char* smem) {
  const u16* knope = p.B2; const u16* vTa = p.B3; const u16* qatt = p.B0; u16* oatt = p.B4;
  u16* sK = (u16*)smem;
  u16* sV = (u16*)(smem + 64 * 400);
  const int tid = TIDX, lane = tid & 63, wave = tid >> 6;
  const int r = lane & 31, hh = lane >> 5;
  for (int pi = BIDX; pi < 512; pi += gridDim.x) {
    const int h = pi & 7, jj = pi >> 3;
    for (int half = 0; half < 2; ++half) {
      const int qb = half ? jj : 127 - jj;
      const int q0 = qb * 128 + wave * 32;
      const int qpos = q0 + r;
      bf16x8 qf[12];
      {
        const u16* qp = qatt + (size_t)qpos * 1536 + h * 192 + hh * 8;
#pragma unroll
        for (int ks = 0; ks < 12; ++ks) qf[ks] = *(const bf16x8*)(qp + ks * 16);
      }
      f32x16 O[4];
#pragma unroll
      for (int mt = 0; mt < 4; ++mt)
#pragma unroll
        for (int i = 0; i < 16; ++i) O[mt][i] = 0.f;
      float m = -INFINITY, l = 0.f;
      const int ntiles = (qb + 1) * 2;
      const u16* knb = knope + h * 128;
      const u16* vtb = vTa + (size_t)h * 128 * S;
      const int offn = (tid >> 4) * 1024 + (tid & 15) * 8;
      const int offr = (tid >> 3) * 64 + (tid & 7) * 8;
      const int offv = (tid >> 3) * S + (tid & 7) * 8;
      u16* dKn = sK + (tid >> 4) * 200 + (tid & 15) * 8;
      u16* dKr = sK + (tid >> 3) * 200 + 128 + (tid & 7) * 8;
      u16* dV = sV + (tid >> 3) * 68 + (tid & 7) * 8;
      for (int t = 0; t < ntiles; ++t) {
        __syncthreads();
        {
          const int k0 = t * 64;
          u32x4 rk[6], rv[4];
#pragma unroll
          for (int i = 0; i < 4; ++i) rk[i] = *(const u32x4*)((knb + (size_t)(k0 + 16 * i) * 1024) + offn);
#pragma unroll
          for (int i = 0; i < 2; ++i) rk[4 + i] = *(const u32x4*)((p.krope + (size_t)(k0 + 32 * i) * 64) + offr);
#pragma unroll
          for (int i = 0; i < 4; ++i) rv[i] = *(const u32x4*)((vtb + (size_t)(32 * i) * S + k0) + offv);
#pragma unroll
          for (int i = 0; i < 4; ++i) *(u32x4*)(dKn + i * 16 * 200) = rk[i];
#pragma unroll
          for (int i = 0; i < 2; ++i) *(u32x4*)(dKr + i * 32 * 200) = rk[4 + i];
#pragma unroll
          for (int i = 0; i < 4; ++i) {
            u32x2* d = (u32x2*)(dV + i * 32 * 68);
            d[0] = u32x2{rv[i][0], rv[i][1]}; d[1] = u32x2{rv[i][2], rv[i][3]};
          }
        }
        __syncthreads();
        const int k0 = t * 64;
        const bool active = (k0 <= q0 + 31);
        f32x16 X[2];
        if (active) {
#pragma unroll
          for (int st = 0; st < 2; ++st) {
#pragma unroll
            for (int i = 0; i < 16; ++i) X[st][i] = 0.f;
#pragma unroll
            for (int ks = 0; ks < 12; ++ks) {
              X[st] = mfma32(*(const bf16x8*)(sK + (st * 32 + r) * 200 + ks * 16 + hh * 8), qf[ks], X[st]);
            }
          }
        }
        if (active) {
          if (k0 + 63 > q0) {
#pragma unroll
            for (int st = 0; st < 2; ++st)
#pragma unroll
              for (int i = 0; i < 16; ++i) {
                const int key = k0 + st * 32 + crow(i, hh);
                if (key > qpos) X[st][i] = -INFINITY;
              }
          }
          float mx = -INFINITY;
#pragma unroll
          for (int st = 0; st < 2; ++st)
#pragma unroll
            for (int i = 0; i < 16; ++i) mx = fmaxf(mx, X[st][i]);
          { const auto sw = __builtin_amdgcn_permlane32_swap(__float_as_uint(mx), __float_as_uint(mx), false, false); mx = fmaxf(__uint_as_float(sw[0]), __uint_as_float(sw[1])); }
          const float mn = fmaxf(m, mx);
          const float alpha = __builtin_amdgcn_exp2f(m - mn);
          m = mn;
          float ps = 0.f;
#pragma unroll
          for (int st = 0; st < 2; ++st)
#pragma unroll
            for (int i = 0; i < 16; ++i) { X[st][i] = __builtin_amdgcn_exp2f(X[st][i] - mn); ps += X[st][i]; }
          l = l * alpha + ps;
          if (__builtin_amdgcn_ballot_w64(alpha != 1.f) != 0ull) {
#pragma unroll
            for (int mt = 0; mt < 4; ++mt)
#pragma unroll
              for (int i = 0; i < 16; ++i) O[mt][i] *= alpha;
          }
#pragma unroll
          for (int st = 0; st < 2; ++st)
#pragma unroll
            for (int k2 = 0; k2 < 2; ++k2) {
              const bf16x8 pf = pack8(X[st][8 * k2 + 0], X[st][8 * k2 + 1], X[st][8 * k2 + 2], X[st][8 * k2 + 3],
                                      X[st][8 * k2 + 4], X[st][8 * k2 + 5], X[st][8 * k2 + 6], X[st][8 * k2 + 7]);
#pragma unroll
              for (int mt = 0; mt < 4; ++mt) {
                const u16* vp = sV + (mt * 32 + r) * 68 + st * 32 + k2 * 16 + hh * 4;
                const s16x4 lo = *(const s16x4*)vp, hi = *(const s16x4*)(vp + 8);
                O[mt] = mfma32(__builtin_shufflevector(lo, hi, 0, 1, 2, 3, 4, 5, 6, 7), pf, O[mt]);
              }
            }
        }
      }
      l += __shfl_xor(l, 32);
      const float inv = 1.f / l;
#pragma unroll
      for (int mt = 0; mt < 4; ++mt)
#pragma unroll
        for (int g4 = 0; g4 < 4; ++g4) {
          const int dv = mt * 32 + 8 * g4 + 4 * hh;
          store4bf(oatt + (size_t)qpos * 1024 + h * 128 + dv, O[mt][4 * g4] * inv, O[mt][4 * g4 + 1] * inv,
                   O[mt][4 * g4 + 2] * inv, O[mt][4 * g4 + 3] * inv);
        }
    }
  }
}

DI void run_phase(int ph, const Params& p, char* smem) {
  switch (ph) {
    case 0: phase_prologue(p, smem); break;
    case 1: phase_inproj(p, smem); break;
    case 2: phase_ml_local(p, smem); break;
    case 3: phase_ml_scan(p); break;
    case 4: phase_ml_out(p, smem); break;
    case 5: phase_outproj(p, 0, p.B0, p.WoaT, p.x, p.F1, smem); break;
    case 6: phase_ln(p.F1, p.B0, p.ln_g, p.ln_b, p.Xq8, p.sxq); break;
    case 7: phase_peer_query(p, 0, p.B0, smem); break;
    case 8: phase_peer_u(p, 0, p.F1, smem); break;
    case 20: phase_peer_v(p, 0, p.F1, p.F2, p.ln_g + 1024, p.ln_b + 1024, smem); break;
    case 9: phase_ple(p, 0, p.F2, p.B1, p.F2, p.B0, smem); break;
    case 10: phase_mla_down(p, p.B0, p.F1, smem); break;
    case 11: phase_mla_norm(p, p.F1); break;
    case 12: phase_mla_up(p, smem); break;
    case 13: phase_attn(p, smem); break;
    case 14: phase_outproj(p, 1, p.B4, p.WobT, p.F2, p.F2, smem); break;
    case 15: phase_ln(p.F2, p.B1, p.ln_g + 2048, p.ln_b + 2048, p.Xq8, p.sxq); break;
    case 16: phase_peer_query(p, 1, p.B1, smem); break;
    case 17: phase_peer_u(p, 1, p.F2, smem); break;
    case 21: phase_peer_v(p, 1, p.F2, p.F1, p.ln_g + 3072, p.ln_b + 3072, smem); break;
    case 18: phase_ple(p, 1, p.F1, p.B0, p.out, nullptr, smem); break;
    default: break;
  }
}


#define XB_TMO      128
#define XB_XCNT(j)  (256  + 64 * (j))
#define XB_XSUB(j)  (1280 + 64 * (j))
#define XB_XGEN(j)  (2304 + 64 * (j))
#define XB_TOP      3328
#define XB_TOPGEN   3392
#define XCD_BAR_WORDS 3456
#define XB_SPIN_CAP (1u << 22)
#define LAS __attribute__((address_space(3)))
DI unsigned xb_ld(unsigned* p) { return __hip_atomic_load(p, __ATOMIC_RELAXED, __HIP_MEMORY_SCOPE_AGENT); }
DI unsigned xb_add(unsigned* p, unsigned v) { return __hip_atomic_fetch_add(p, v, __ATOMIC_RELAXED, __HIP_MEMORY_SCOPE_AGENT); }
DI unsigned xb_xcc_id() { return (unsigned)__builtin_amdgcn_s_getreg((3 << 11) | 20) & 0xFu; }
#define XB_SPIN(cond, bar) do { unsigned _sp = 0; while (cond) { __builtin_amdgcn_s_sleep(1); \
    if ((++_sp & 255u) == 0u) { if (xb_ld(&(bar)[XB_TMO])) break; if (_sp > XB_SPIN_CAP) { atomicAdd(&(bar)[XB_TMO], 1u); break; } } } } while (0)
struct XcdBarrier { unsigned* bar; unsigned x; volatile LAS unsigned* st; };
DI XcdBarrier xcd_barrier_post(unsigned* bar, volatile LAS unsigned* st) {
  XcdBarrier b; b.bar = bar; b.x = xb_xcc_id(); b.st = st;
  if (TIDX == 0) (void)xb_add(&bar[XB_XCNT(b.x)], 1u);
  return b;
}
DI void xcd_barrier_complete(unsigned* bar, unsigned x, unsigned& nloc, unsigned& nx) {
  const unsigned G = gridDim.x * gridDim.y * gridDim.z;
  unsigned sum, cnt, mine, sp = 0u;
  for (;;) {
    sum = 0u; cnt = 0u; mine = 0u;
#pragma unroll
    for (unsigned j = 0; j < 16; ++j) { const unsigned c = xb_ld(&bar[XB_XCNT(j)]); sum += c; cnt += (c > 0u) ? 1u : 0u; mine = (j == x) ? c : mine; }
    if (sum == G) break;
    __builtin_amdgcn_s_sleep(1);
    if ((++sp & 255u) == 0u) { if (xb_ld(&bar[XB_TMO])) break; if (sp > XB_SPIN_CAP) { atomicAdd(&bar[XB_TMO], 1u); break; } }
  }
  nloc = mine > 0u ? mine : 1u; nx = cnt > 0u ? cnt : 1u;
}
DI void xcd_barrier(const XcdBarrier& b) {
  asm volatile("s_waitcnt vmcnt(0)" ::: "memory");
  __syncthreads();
  if (TIDX == 0) {
    unsigned* bar = b.bar;
    __builtin_amdgcn_s_waitcnt(0);
    unsigned nloc = b.st[0], nx = b.st[1];
    if (nloc == 0u) { xcd_barrier_complete(bar, b.x, nloc, nx); b.st[0] = nloc; b.st[1] = nx; }
    const unsigned old = xb_add(&bar[XB_XSUB(b.x)], 1u);
    const unsigned gen = old / nloc;
    if (old + 1u == (gen + 1u) * nloc) {
      __builtin_amdgcn_fence(__ATOMIC_RELEASE, "agent");
      asm volatile("s_waitcnt vmcnt(0)" ::: "memory");
      const unsigned og = xb_add(&bar[XB_TOP], 1u);
      const unsigned tg = og / nx;
      if (og + 1u == (tg + 1u) * nx) xb_add(&bar[XB_TOPGEN], 1u);
      else XB_SPIN(xb_ld(&bar[XB_TOPGEN]) == tg, bar);
      __builtin_amdgcn_fence(__ATOMIC_ACQUIRE, "agent");
      xb_add(&bar[XB_XGEN(b.x)], 1u);
      asm volatile("s_waitcnt vmcnt(0)" ::: "memory");
    } else {
      XB_SPIN(xb_ld(&bar[XB_XGEN(b.x)]) == gen, bar);
      __builtin_amdgcn_fence(__ATOMIC_ACQUIRE, "agent");
      asm volatile("s_waitcnt vmcnt(0)" ::: "memory");
    }
  }
  __syncthreads();
}

#ifndef DUP_MASK
#define DUP_MASK 0u
#endif
#define RUNP(k) { run_phase(k, p, smem); xcd_barrier(xb); if ((DUP_MASK >> (k)) & 1u) { run_phase(k, p, smem); xcd_barrier(xb); } }
#if MEGA
__global__ void __launch_bounds__(256, 2) mega_kernel(Params p) {
  __shared__ __attribute__((aligned(16))) char smem[SMEM_BYTES];
  __shared__ uint4 xb_words;
  cg::grid_group grid = cg::this_grid();
  if (TIDX == 0) xb_words = make_uint4(0u, 0u, 0u, 0u);
  __syncthreads();
  XcdBarrier xb = xcd_barrier_post(p.bar, (volatile LAS unsigned*)&xb_words);
  if (p.out == nullptr) grid.sync();
  RUNP(0) RUNP(1)
  RUNP(2) RUNP(3) RUNP(4) RUNP(5) RUNP(6) RUNP(7) RUNP(8) RUNP(20) RUNP(9)
  RUNP(10) RUNP(11) RUNP(12) RUNP(13) RUNP(14) RUNP(15) RUNP(16) RUNP(17) RUNP(21)
  run_phase(18, p, smem);
}
#else
__global__ void __launch_bounds__(256, 2) phase_kernel(Params p, int ph) {
  __shared__ __attribute__((aligned(16))) char smem[SMEM_BYTES];
  run_phase(ph, p, smem);
}
#endif

extern "C" void kernel_launch(void* const* d_in, const int* in_sizes, int n_in, void* d_out, int out_size, void* d_ws,
                              size_t ws_size, hipStream_t stream) {
  Params p{};
  p.x = (const float*)d_in[0]; p.p = (const float*)d_in[1]; p.pos = (const int*)d_in[2];
  p.ln_g = (const float*)d_in[3]; p.ln_b = (const float*)d_in[4]; p.a_w_in = (const float*)d_in[5];
  p.a_b_if = (const float*)d_in[6]; p.a_hn_g = (const float*)d_in[7]; p.a_w_out = (const float*)d_in[8];
  p.kv_w_down = (const float*)d_in[9]; p.kv_norm_g = (const float*)d_in[10]; p.kv_w_up = (const float*)d_in[11];
  p.b_w_dq = (const float*)d_in[12]; p.b_q_norm_g = (const float*)d_in[13]; p.b_w_uq = (const float*)d_in[14];
  p.b_w_out = (const float*)d_in[15]; p.peer_w_q = (const float*)d_in[16]; p.peer_sub_keys = (const float*)d_in[17];
  p.peer_u = (const float*)d_in[18]; p.peer_v = (const float*)d_in[19]; p.ple_w_proj = (const float*)d_in[20];
  p.ple_w_gate = (const float*)d_in[21];
  p.out = (float*)d_out;
  char* w = (char*)d_ws;
  size_t off = 0;
  auto take = [&](size_t bytes) { char* r = w + off; off += (bytes + 255) & ~(size_t)255; return r; };
  const size_t MB = 1024 * 1024;
  p.WinT = (u16*)take((size_t)3200 * 1024 * 2);
  p.WoaT = (u16*)take(2 * MB);
  p.WpqT = (u16*)take(8 * MB);
  p.SubK = (u16*)take(1 * MB);
  p.WgT = (u16*)take(4 * MB);
  p.WpT = (u16*)take(1 * MB);
  p.WdT = (u16*)take((size_t)768 * 1024 * 2);
  p.WupT = (u16*)take(1 * MB);
  p.WuqT = (u16*)take((size_t)1536 * 384 * 2);
  p.WobT = (u16*)take(2 * MB);
  p.Uq = (u8*)take(32 * MB);
  p.Vq = (u8*)take(32 * MB);
  p.scU = (float*)take(2 * 16384 * 4);
  p.scV = (float*)take(2 * 16384 * 4);
  p.Xq8 = (u8*)take((size_t)S * 1024);
  p.Wq8 = (u8*)take((size_t)2 * 2048 * 1024);
  p.sxq = (float*)take((size_t)S * 4);
  p.swq = (float*)take(2 * 2048 * 4);
  p.Wg8 = (u8*)take((size_t)2 * 1024 * 1024);
  p.swg = (float*)take(2 * 1024 * 4);
  p.Win8 = (u8*)take((size_t)3200 * 1024);
  p.swin = (float*)take(3200 * 4);
  p.pb = (u16*)take(16 * MB);
  p.F1 = (float*)take(64 * MB);
  p.F2 = (float*)take(64 * MB);
  p.B0 = (u16*)take(32 * MB);
  p.B1 = (u16*)take(32 * MB);
  p.B2 = (u16*)take(32 * MB);
  p.B3 = (u16*)take(32 * MB);
  p.B4 = (u16*)take(32 * MB);
  p.B6 = (u16*)take(16 * MB);
  p.igf = (float*)take((size_t)S * 8 * 4);
  p.lf = (float*)take((size_t)S * 8 * 4);
  p.dn = (float*)take((size_t)2048 * 64 * 4);
  p.nprev = (float*)take((size_t)2048 * 64 * 4);
  p.blast = (float*)take(2048 * 4);
  p.mloc = (float*)take(2048 * 4);
  p.mprev = (float*)take(2048 * 4);
  p.ropec = (float*)take((size_t)S * 32 * 4);
  p.ropes = (float*)take((size_t)S * 32 * 4);
  p.ckvb = (u16*)take((size_t)S * 256 * 2);
  p.cqb = (u16*)take((size_t)S * 384 * 2);
  p.krope = (u16*)take((size_t)S * 64 * 2);
  p.bar = (unsigned*)take(XCD_BAR_WORDS * 4);
  if (off > ws_size) { fprintf(stderr, "workspace too small: need %zu have %zu\n", off, ws_size); return; }
#if MEGA
  static int grid_blocks = 0;
  if (!grid_blocks) {
    int dev = 0, cus = 0, per_cu = 0;
    hipGetDevice(&dev);
    hipDeviceGetAttribute(&cus, hipDeviceAttributeMultiprocessorCount, dev);
    hipOccupancyMaxActiveBlocksPerMultiprocessor(&per_cu, mega_kernel, 256, 0);
    if (per_cu > 2) per_cu = 2;
    grid_blocks = cus * per_cu;
  }
  (void)hipMemsetAsync(p.bar, 0, XCD_BAR_WORDS * 4, stream);
  void* args[] = {&p};
  hipError_t e = hipLaunchCooperativeKernel((void*)mega_kernel, dim3(grid_blocks), dim3(256), args, 0, stream);
  if (e != hipSuccess) fprintf(stderr, "cooperative launch failed: %s (grid %d)\n", hipGetErrorString(e), grid_blocks);
#else
  for (int ph = 0; ph < 19; ++ph) hipLaunchKernelGGL(phase_kernel, dim3(512), dim3(256), 0, stream, p, ph);
#endif
}
```
